# Optimizing an MI355X kernel written in HIP

```python
import math
import jax, jax.numpy as jnp
from jax import lax
import numpy as np

D_MODEL = 1024
BATCH = 16
SEQ = 2048
DEPTH = 1

ATTN_HEADS = 8
HEAD_DIM = 64
ATTN_WIDTH = ATTN_HEADS * HEAD_DIM
GMLP_GROUPS = 4
GMLP_GROUP_DIM = 128
GMLP_WIDTH = GMLP_GROUPS * GMLP_GROUP_DIM
MIX_WIDTH = ATTN_WIDTH + GMLP_WIDTH
IN_WIDTH = 3 * ATTN_WIDTH + 2 * GMLP_WIDTH
CHUNK = 128
WINDOW_DILATIONS = ((128, 1), (512, 4), (2048, 16))
BLOCK = 128
D_FF = 4 * D_MODEL
EPS = 1e-6

kernel_name = "hybrid_dilated_attn_gmlp_block"


def rms_norm(x, g):
    xf = x.astype(jnp.float32)
    y = xf * lax.rsqrt(jnp.mean(xf * xf, axis=-1, keepdims=True) + EPS)
    return (y * g.astype(jnp.float32)).astype(x.dtype)


def layer_norm(x, g, b):
    xf = x.astype(jnp.float32)
    mu = jnp.mean(xf, axis=-1, keepdims=True)
    var = jnp.mean(jnp.square(xf - mu), axis=-1, keepdims=True)
    y = (xf - mu) * lax.rsqrt(var + EPS)
    return (y * g.astype(jnp.float32) + b.astype(jnp.float32)).astype(x.dtype)


def causal_window_attention(q, k, v, span):
    N, L, H, D = q.shape
    Lp = -(-L // BLOCK) * BLOCK
    pad = Lp - L
    if pad:
        pw = ((0, 0), (0, pad), (0, 0), (0, 0))
        q, k, v = jnp.pad(q, pw), jnp.pad(k, pw), jnp.pad(v, pw)
    nb = Lp // BLOCK
    qb = q.reshape(N, nb, BLOCK, H, D)
    kb = k.reshape(N, nb, BLOCK, H, D)
    vb = v.reshape(N, nb, BLOCK, H, D)
    k_prev = jnp.concatenate([jnp.zeros_like(kb[:, :1]), kb[:, :-1]], axis=1)
    v_prev = jnp.concatenate([jnp.zeros_like(vb[:, :1]), vb[:, :-1]], axis=1)
    kk = jnp.concatenate([k_prev, kb], axis=2)
    vv = jnp.concatenate([v_prev, vb], axis=2)
    scale = 1.0 / math.sqrt(D)
    s = jnp.einsum('nbqhd,nbkhd->nbhqk', qb, kk).astype(jnp.float32) * scale
    qpos = jnp.arange(BLOCK)[:, None] + BLOCK
    kpos = jnp.arange(2 * BLOCK)[None, :]
    dist = qpos - kpos
    band = (dist >= 0) & (dist <= span)
    first = (jnp.arange(nb)[:, None, None] == 0) & (kpos[None] < BLOCK)
    mask = band[None] & ~first
    s = jnp.where(mask[None, :, None], s, -jnp.inf)
    m = jnp.max(s, axis=-1, keepdims=True)
    p = jnp.exp(s - m)
    den = jnp.sum(p, axis=-1)
    o = jnp.einsum('nbhqk,nbkhd->nbqhd', p.astype(vv.dtype), vv).astype(jnp.float32)
    o = o / jnp.transpose(den, (0, 1, 3, 2))[..., None]
    lse = m[..., 0] + jnp.log(den)
    o = o.reshape(N, Lp, H, D)[:, :L]
    lse = jnp.transpose(lse, (0, 1, 3, 2)).reshape(N, Lp, H)[:, :L]
    return o, lse


def dilated_branch(q, k, v, window, dilation):
    B, S, H, D = q.shape
    L = S // dilation

    def to_residue(t):
        return t.reshape(B, L, dilation, H, D).transpose(0, 2, 1, 3, 4).reshape(B * dilation, L, H, D)

    o, lse = causal_window_attention(to_residue(q), to_residue(k), to_residue(v), window // dilation)
    o = o.reshape(B, dilation, L, H, D).transpose(0, 2, 1, 3, 4).reshape(B, S, H, D)
    lse = lse.reshape(B, dilation, L, H).transpose(0, 2, 1, 3).reshape(B, S, H)
    return o, lse


def dilated_attention(q, k, v):
    outs, lses = [], []
    for window, dilation in WINDOW_DILATIONS:
        o, lse = dilated_branch(q, k, v, window, dilation)
        outs.append(o)
        lses.append(lse)
    o = jnp.stack(outs, axis=0)
    w = jax.nn.softmax(jnp.stack(lses, axis=0), axis=0)
    return jnp.sum(w[..., None] * o, axis=0)


def spatial_gating(u, g, ln_g, ln_b, w_s, b_s):
    B, S, _ = u.shape
    nc = S // CHUNK
    g = g.reshape(B, S, GMLP_GROUPS, GMLP_GROUP_DIM)
    g = layer_norm(g, ln_g, ln_b)
    g = g.reshape(B, nc, CHUNK, GMLP_GROUPS, GMLP_GROUP_DIM)
    causal = jnp.tril(jnp.ones((CHUNK, CHUNK), dtype=bool))
    w_m = jnp.where(causal[None], w_s, 0.0).astype(g.dtype)
    z = jnp.einsum('gts,bnsgc->bntgc', w_m, g) + b_s.T[None, None, :, :, None]
    z = z.reshape(B, S, GMLP_WIDTH)
    return u * z


def setup_inputs(seed: int = 0) -> dict:
    key = jax.random.key(seed)
    ks = jax.random.split(key, 16)
    f32 = jnp.float32

    def nrm(k, shape, scale):
        return jax.random.normal(k, shape, f32) * scale

    L = DEPTH
    return {
        "x": jax.random.normal(ks[0], (BATCH, SEQ, D_MODEL), f32),
        "norm1_g": 1.0 + nrm(ks[1], (L, D_MODEL), 0.02),
        "w_in": nrm(ks[2], (L, D_MODEL, IN_WIDTH), D_MODEL ** -0.5),
        "q_norm_g": 1.0 + nrm(ks[3], (L, HEAD_DIM), 0.02),
        "k_norm_g": 1.0 + nrm(ks[4], (L, HEAD_DIM), 0.02),
        "ln_v_g": 1.0 + nrm(ks[5], (L, GMLP_GROUPS, GMLP_GROUP_DIM), 0.02),
        "ln_v_b": nrm(ks[6], (L, GMLP_GROUPS, GMLP_GROUP_DIM), 0.02),
        "w_spatial": nrm(ks[7], (L, GMLP_GROUPS, CHUNK, CHUNK), CHUNK ** -0.5),
        "b_spatial": 1.0 + nrm(ks[8], (L, GMLP_GROUPS, CHUNK), 0.1),
        "attn_out_g": 1.0 + nrm(ks[9], (L, ATTN_WIDTH), 0.02),
        "gmlp_out_g": 1.0 + nrm(ks[10], (L, GMLP_WIDTH), 0.02),
        "w_out": nrm(ks[11], (L, MIX_WIDTH, D_MODEL), MIX_WIDTH ** -0.5),
        "norm2_g": 1.0 + nrm(ks[12], (L, D_MODEL), 0.02),
        "w_ff1": nrm(ks[13], (L, D_MODEL, D_FF), D_MODEL ** -0.5),
        "w_ff2": nrm(ks[14], (L, D_FF, D_MODEL), D_FF ** -0.5),
    }


def reference(x, norm1_g, w_in, q_norm_g, k_norm_g, ln_v_g, ln_v_b, w_spatial,
              b_spatial, attn_out_g, gmlp_out_g, w_out, norm2_g, w_ff1, w_ff2):
    B, S, _ = x.shape
    for l in range(DEPTH):
        h = rms_norm(x, norm1_g[l])
        proj = jnp.einsum('bsd,de->bse', h, w_in[l])
        q, k, v, u, g = jnp.split(
            proj, np.cumsum([ATTN_WIDTH] * 3 + [GMLP_WIDTH]).tolist(), axis=-1)
        q = rms_norm(q.reshape(B, S, ATTN_HEADS, HEAD_DIM), q_norm_g[l])
        k = rms_norm(k.reshape(B, S, ATTN_HEADS, HEAD_DIM), k_norm_g[l])
        v = v.reshape(B, S, ATTN_HEADS, HEAD_DIM)
        a = dilated_attention(q, k, v).astype(x.dtype).reshape(B, S, ATTN_WIDTH)
        m = spatial_gating(jax.nn.gelu(u), jax.nn.gelu(g), ln_v_g[l], ln_v_b[l],
                           w_spatial[l], b_spatial[l])
        mix = jnp.concatenate([rms_norm(a, attn_out_g[l]), rms_norm(m, gmlp_out_g[l])], axis=-1)
        x = x + jnp.einsum('bse,ed->bsd', mix, w_out[l])
        h = rms_norm(x, norm2_g[l])
        f = jnp.square(jax.nn.relu(jnp.einsum('bsd,df->bsf', h, w_ff1[l])))
        x = x + jnp.einsum('bsf,fd->bsd', f, w_ff2[l])
    return x
```

```cpp
#include <hip/hip_runtime.h>
#include <hip/hip_cooperative_groups.h>
#include <cstdio>
#include <cstdint>
namespace cg = cooperative_groups;

#define LAS __attribute__((address_space(3)))
typedef unsigned short bf16_t;
typedef short bf16x8 __attribute__((ext_vector_type(8)));
typedef float f32x4 __attribute__((ext_vector_type(4)));
typedef float f32x2 __attribute__((ext_vector_type(2)));
typedef float f32x16 __attribute__((ext_vector_type(16)));
typedef unsigned u32x4 __attribute__((ext_vector_type(4)));
typedef unsigned u32x2 __attribute__((ext_vector_type(2)));
typedef __bf16 bf16x2_t __attribute__((ext_vector_type(2)));

constexpr int BATCH = 16, SEQ = 2048, DM = 1024, M = BATCH * SEQ;
constexpr int NH = 8, HD = 64, AW = 512, GW = 512, NIN = 2560, FF = 4096;
constexpr float EPS = 1e-6f;
constexpr float C2 = 0.125f * 1.4426950408889634f;

__device__ __forceinline__ unsigned pk2(float lo, float hi) { f32x2 v = {lo, hi}; bf16x2_t b = __builtin_convertvector(v, bf16x2_t); return __builtin_bit_cast(unsigned, b); }
__device__ __forceinline__ float bf2f(unsigned short b) { return __builtin_bit_cast(float, (unsigned)b << 16); }
__device__ __forceinline__ float gelu_t(float x) {
    const float t = x * (1.0f + 0.044715f * x * x) * (-2.0f * 0.7978845608028654f * 1.4426950408889634f);
    return x * __builtin_amdgcn_rcpf(1.0f + __builtin_amdgcn_exp2f(t));
}
__device__ __forceinline__ float row16_sum(float v) {
    v += __builtin_bit_cast(float, __builtin_amdgcn_update_dpp(0, __builtin_bit_cast(int, v), 0x128, 0xf, 0xf, true));
    v += __builtin_bit_cast(float, __builtin_amdgcn_update_dpp(0, __builtin_bit_cast(int, v), 0x124, 0xf, 0xf, true));
    v += __builtin_bit_cast(float, __builtin_amdgcn_update_dpp(0, __builtin_bit_cast(int, v), 0x4E, 0xf, 0xf, true));
    v += __builtin_bit_cast(float, __builtin_amdgcn_update_dpp(0, __builtin_bit_cast(int, v), 0xB1, 0xf, 0xf, true));
    return v;
}
__device__ __forceinline__ float xor16_32_sum(float v) {
    { const auto r = __builtin_amdgcn_permlane16_swap(__float_as_uint(v), __float_as_uint(v), false, false); v = __uint_as_float(r[0]) + __uint_as_float(r[1]); }
    { const auto r = __builtin_amdgcn_permlane32_swap(__float_as_uint(v), __float_as_uint(v), false, false); v = __uint_as_float(r[0]) + __uint_as_float(r[1]); }
    return v;
}
__device__ __forceinline__ float xor32_sum(float v) {
    const auto r = __builtin_amdgcn_permlane32_swap(__float_as_uint(v), __float_as_uint(v), false, false); return __uint_as_float(r[0]) + __uint_as_float(r[1]);
}
__device__ __forceinline__ float wave_sum(float v) { return xor16_32_sum(row16_sum(v)); }
__device__ __forceinline__ float wave_max(float v) {
#pragma unroll
    for (int o = 1; o < 64; o <<= 1) v = fmaxf(v, __shfl_xor(v, o));
    return v;
}

namespace pg8 {
constexpr int BM = 256, BK = 64, HALF = 128, HTB = HALF * BK * 2, STAGE_BYTES = 8 * HTB, NXCD = 8, WGM = 8;
__host__ __device__ __forceinline__ int lds_byte(int r, int c) { const int st = (r >> 4) * 2 + (c >> 5), rr = r & 15, cc = c & 31, ob = rr * 64 + cc * 2; return st * 1024 + (ob ^ (((ob >> 9) & 1) << 5)); }
__host__ __device__ __forceinline__ void stage_rc(int b, int& R, int& C) { const int st = b / 1024, sb = b % 1024, swz = sb ^ (((sb >> 9) & 1) << 5); R = (st >> 1) * 16 + swz / 64; C = (st & 1) * 32 + (swz % 64) / 2; }
__host__ __device__ __forceinline__ int perm32(int rho) { const int n = rho >> 4, i = rho & 15; return 8 * (i >> 2) + 4 * n + (i & 3); }

struct Unit { int pm, pn; };
struct Gemm { const bf16_t* A; const bf16_t* Bt; int M, N, K; int lda; int kstepA; };
struct StaticOrder {
    int nM, nN, nwg, G, c, rep, pm0;
    __device__ void init(int M_, int N_, int G_, int c_, int rep_ = 1, int pm0_ = 0) { nM = M_ / BM; nN = N_ / BM; nwg = nM * nN; G = G_; c = c_; rep = rep_; pm0 = pm0_; }
    __device__ bool next(int i, Unit& u) const {
        const long L = (long)i * G + c; if (L >= (long)nwg * rep) return false;
        int wgid = (int)(L % nwg); { const int q = nwg / NXCD, r = nwg % NXCD, xcd = wgid % NXCD, off = wgid / NXCD; wgid = (xcd < r ? xcd * (q + 1) : r * (q + 1) + (xcd - r) * q) + off; }
        const int nig = WGM * nN, gid = wgid / nig, fm = gid * WGM, gsz = (nM - fm) < WGM ? (nM - fm) : WGM;
        u.pm = pm0 + fm + ((wgid % nig) % gsz); u.pn = (wgid % nig) / gsz; return true;
    }
};

struct EpiIn {
    static constexpr bool HEADPERM = true, MID = false;
    bf16_t *Q, *Kp, *Vt, *U, *G; const float *gq, *gk;
    __device__ __forceinline__ void operator()(const f32x4 (&acc)[2][2][4][2], const Unit& u, int wr, int wc, int fr, int fq) const {
        const int sec = u.pn >> 1, half = u.pn & 1, b = u.pm >> 3, pml = u.pm & 7;
        if (sec <= 1) {
            const float* gp = sec == 0 ? gq : gk; const float sc = sec == 0 ? C2 : 1.0f;
            f32x4 gv[2][2];
#pragma unroll
            for (int bj = 0; bj < 2; ++bj)
#pragma unroll
                for (int n = 0; n < 2; ++n) gv[bj][n] = *(const f32x4*)(gp + 32 * bj + 8 * fq + 4 * n) * sc;
            bf16_t* base = (sec == 0 ? Q : Kp) + (size_t)(((b * 8 + half * 4 + wc) * 16 + fr) * 128) * 64;
#pragma unroll
            for (int ai = 0; ai < 2; ++ai)
#pragma unroll
                for (int m = 0; m < 4; ++m) {
                    float s = 0.f;
#pragma unroll
                    for (int bj = 0; bj < 2; ++bj)
#pragma unroll
                        for (int n = 0; n < 2; ++n) { const f32x4 x = acc[ai][bj][m][n]; s += (x[0] * x[0] + x[1] * x[1]) + (x[2] * x[2] + x[3] * x[3]); }
                    s = xor16_32_sum(s);
                    const float r = rsqrtf(s * (1.0f / 64.0f) + EPS);
                    const int i = 16 * pml + 8 * wr + 4 * ai + m;
#pragma unroll
                    for (int bj = 0; bj < 2; ++bj) {
                        const f32x4 v0 = acc[ai][bj][m][0] * r * gv[bj][0], v1 = acc[ai][bj][m][1] * r * gv[bj][1];
                        u32x4 w; w.x = pk2(v0[0], v0[1]); w.y = pk2(v0[2], v0[3]); w.z = pk2(v1[0], v1[1]); w.w = pk2(v1[2], v1[3]);
                        *(u32x4*)(base + (size_t)i * 64 + 32 * bj + 8 * fq) = w;
                    }
                }
        } else if (sec == 2) {
            bf16_t* base = Vt + (size_t)((((b * 8 + half * 4 + wc) * 16 + fr) * 16 + (2 * pml + wr)) * 64) * 8;
#pragma unroll
            for (int bj = 0; bj < 2; ++bj)
#pragma unroll
                for (int n = 0; n < 2; ++n)
#pragma unroll
                    for (int j = 0; j < 4; ++j) {
                        const int d = 32 * bj + 8 * fq + 4 * n + j;
                        u32x4 w;
                        w.x = pk2(acc[0][bj][0][n][j], acc[0][bj][1][n][j]); w.y = pk2(acc[0][bj][2][n][j], acc[0][bj][3][n][j]);
                        w.z = pk2(acc[1][bj][0][n][j], acc[1][bj][1][n][j]); w.w = pk2(acc[1][bj][2][n][j], acc[1][bj][3][n][j]);
                        *(u32x4*)(base + (size_t)d * 8) = w;
                    }
        } else {
            bf16_t* base = (sec == 3 ? U : G);
            const int col0 = 256 * half + 64 * wc + 8 * fq;
#pragma unroll
            for (int ai = 0; ai < 2; ++ai)
#pragma unroll
                for (int m = 0; m < 4; ++m) {
                    const size_t row = (size_t)u.pm * 256 + 128 * wr + 64 * ai + 16 * m + fr;
#pragma unroll
                    for (int bj = 0; bj < 2; ++bj) {
                        const f32x4 a0 = acc[ai][bj][m][0], a1 = acc[ai][bj][m][1];
                        u32x4 w; w.x = pk2(gelu_t(a0[0]), gelu_t(a0[1])); w.y = pk2(gelu_t(a0[2]), gelu_t(a0[3]));
                        w.z = pk2(gelu_t(a1[0]), gelu_t(a1[1])); w.w = pk2(gelu_t(a1[2]), gelu_t(a1[3]));
                        *(u32x4*)(base + row * 512 + col0 + 32 * bj) = w;
                    }
                }
        }
    }
};
struct EpiOut {
    static constexpr bool HEADPERM = false, MID = true;
    const float* x; bf16_t* XB; float* ssq; const float* ssqA;
    __device__ __forceinline__ void mid(f32x4 (&acc)[2][2][4][2], const Unit& u, int wr, int wc, int fr, int fq) const {
#pragma unroll
        for (int ai = 0; ai < 2; ++ai)
#pragma unroll
            for (int m = 0; m < 4; ++m) {
                const size_t row = (size_t)u.pm * 256 + 128 * wr + 64 * ai + 16 * m + fr;
                const f32x4* sp = (const f32x4*)(ssqA + row * 8);
                const f32x4 t = sp[0] + sp[1];
                const float r = rsqrtf(((t[0] + t[1]) + (t[2] + t[3])) * (1.0f / AW) + EPS);
#pragma unroll
                for (int bj = 0; bj < 2; ++bj)
#pragma unroll
                    for (int n = 0; n < 2; ++n) acc[ai][bj][m][n] = acc[ai][bj][m][n] * r;
            }
    }
    __device__ __forceinline__ void operator()(const f32x4 (&acc)[2][2][4][2], const Unit& u, int wr, int wc, int fr, int fq) const {
#pragma unroll
        for (int ai = 0; ai < 2; ++ai)
#pragma unroll
            for (int m = 0; m < 4; ++m) {
                const size_t row = (size_t)u.pm * 256 + 128 * wr + 64 * ai + 16 * m + fr;
                const size_t off = row * DM + 256 * u.pn + 32 * wc + 8 * fq;
                float s = 0.f;
#pragma unroll
                for (int bj = 0; bj < 2; ++bj) {
                    const f32x4 v0 = *(const f32x4*)(x + off + 128 * bj) + acc[ai][bj][m][0], v1 = *(const f32x4*)(x + off + 128 * bj + 4) + acc[ai][bj][m][1];
                    s += (v0[0] * v0[0] + v0[1] * v0[1]) + (v0[2] * v0[2] + v0[3] * v0[3]) + (v1[0] * v1[0] + v1[1] * v1[1]) + (v1[2] * v1[2] + v1[3] * v1[3]);
                    u32x4 w; w.x = pk2(v0[0], v0[1]); w.y = pk2(v0[2], v0[3]); w.z = pk2(v1[0], v1[1]); w.w = pk2(v1[2], v1[3]);
                    *(u32x4*)(XB + off + 128 * bj) = w;
                }
                s = xor16_32_sum(s);
                if (fq == 0) ssq[row * 16 + u.pn * 4 + wc] = s;
            }
    }
};
struct EpiUp {
    static constexpr bool HEADPERM = false, MID = false;
    bf16_t* H; const float* ssq;
    __device__ __forceinline__ void operator()(const f32x4 (&acc)[2][2][4][2], const Unit& u, int wr, int wc, int fr, int fq) const {
#pragma unroll
        for (int ai = 0; ai < 2; ++ai)
#pragma unroll
            for (int m = 0; m < 4; ++m) {
                const size_t row = (size_t)u.pm * 256 + 128 * wr + 64 * ai + 16 * m + fr;
                const f32x4* sp = (const f32x4*)(ssq + row * 16);
                const f32x4 t = (sp[0] + sp[1]) + (sp[2] + sp[3]);
                const float r = rsqrtf(((t[0] + t[1]) + (t[2] + t[3])) * (1.0f / DM) + EPS);
                const size_t off = (((size_t)u.pm * 64 + 4 * u.pn + (wc >> 1)) * 256 + (128 * wr + 64 * ai + 16 * m + fr)) * 64 + 32 * (wc & 1) + 8 * fq;
#pragma unroll
                for (int bj = 0; bj < 2; ++bj) {
                    f32x4 v0 = acc[ai][bj][m][0] * r, v1 = acc[ai][bj][m][1] * r;
#pragma unroll
                    for (int j = 0; j < 4; ++j) { v0[j] = fmaxf(v0[j], 0.f); v1[j] = fmaxf(v1[j], 0.f); }
                    v0 = v0 * v0; v1 = v1 * v1;
                    u32x4 w; w.x = pk2(v0[0], v0[1]); w.y = pk2(v0[2], v0[3]); w.z = pk2(v1[0], v1[1]); w.w = pk2(v1[2], v1[3]);
                    *(u32x4*)(H + off + (size_t)bj * (2 * 256 * 64)) = w;
                }
            }
    }
};
struct EpiDown {
    static constexpr bool HEADPERM = false, MID = false;
    float* out; const bf16_t* XB;
    __device__ __forceinline__ void operator()(const f32x4 (&acc)[2][2][4][2], const Unit& u, int wr, int wc, int fr, int fq) const {
#pragma unroll
        for (int ai = 0; ai < 2; ++ai)
#pragma unroll
            for (int m = 0; m < 4; ++m) {
                const size_t row = (size_t)u.pm * 256 + 128 * wr + 64 * ai + 16 * m + fr;
                const size_t off = row * DM + 256 * u.pn + 32 * wc + 8 * fq;
#pragma unroll
                for (int bj = 0; bj < 2; ++bj) {
                    const u32x4 xr = *(const u32x4*)(XB + off + 128 * bj);
                    f32x4 v0, v1;
                    v0[0] = __builtin_bit_cast(float, xr[0] << 16); v0[1] = __builtin_bit_cast(float, xr[0] & 0xffff0000u); v0[2] = __builtin_bit_cast(float, xr[1] << 16); v0[3] = __builtin_bit_cast(float, xr[1] & 0xffff0000u);
                    v1[0] = __builtin_bit_cast(float, xr[2] << 16); v1[1] = __builtin_bit_cast(float, xr[2] & 0xffff0000u); v1[2] = __builtin_bit_cast(float, xr[3] << 16); v1[3] = __builtin_bit_cast(float, xr[3] & 0xffff0000u);
                    *(f32x4*)(out + off + 128 * bj) = v0 + acc[ai][bj][m][0]; *(f32x4*)(out + off + 128 * bj + 4) = v1 + acc[ai][bj][m][1];
                }
            }
    }
};

template <class Epi, class Sched>
__device__ __forceinline__ void gemm_prestage_b(LAS unsigned char* lds, const Gemm g, const Sched& S) {
    int tid_ = threadIdx.x; asm volatile("" : "+v"(tid_));
    const int tid = tid_, wid = __builtin_amdgcn_readfirstlane(tid >> 6);
    Unit cur; if (!S.next(0, cur)) return;
    const int K = g.K;
    const char* cB = (const char*)g.Bt + (size_t)cur.pn * ((size_t)256 * K * 2);
    const size_t hstepB = (size_t)(Epi::HEADPERM ? 32 : 128) * K * 2;
    const unsigned lds_u32 = (unsigned)(size_t)lds, ldsw = (unsigned)wid * 1024u;
#pragma unroll
    for (int hb = 0; hb < 2; ++hb)
#pragma unroll
        for (int i = 0; i < 2; ++i) { int R, C; stage_rc(tid * 16 + i * 8192, R, C);
            const int Rb = Epi::HEADPERM ? (64 * (R >> 5) + perm32(R & 31)) : ((R & ~31) + perm32(R & 31));
            const unsigned voff = (unsigned)(Rb * K + C) * 2u; unsigned keep;
            const unsigned ld = (unsigned)__builtin_amdgcn_readfirstlane((int)(lds_u32 + (unsigned)((4 + hb) * HTB) + ldsw + (unsigned)(i * 8192)));
            asm volatile("s_mov_b32 %0, m0\n\ts_mov_b32 m0, %2\n\ts_nop 0\n\tglobal_load_lds_dwordx4 %1, %3\n\ts_mov_b32 m0, %0"
                         : "=&s"(keep) : "v"(voff), "s"(ld), "s"(cB + hb * hstepB) : "memory"); }
}
template <class Epi, class Sched>
__device__ __forceinline__ void gemm_phase(LAS unsigned char* lds, const Gemm g, const Sched& S, const Epi& E, const bool b_prestaged = false) {
    int tid_ = threadIdx.x; asm volatile("" : "+v"(tid_));
    const int tid = tid_, wid = __builtin_amdgcn_readfirstlane(tid >> 6), lane = tid & 63, wr = wid >> 2, wc = wid & 3, fr = lane & 15, fq = lane >> 4;
    const int K = g.K, nt = K / BK;
    unsigned voffA[2], voffB[2];
#pragma unroll
    for (int i = 0; i < 2; ++i) { int R, C; stage_rc(tid * 16 + i * 8192, R, C);
        const int Ra = 128 * (R >> 6) + (R & 63);
        const int Rb = Epi::HEADPERM ? (64 * (R >> 5) + perm32(R & 31)) : ((R & ~31) + perm32(R & 31));
        voffA[i] = (unsigned)(Ra * g.lda + C) * 2u; voffB[i] = (unsigned)(Rb * K + C) * 2u; }
    const size_t kstep = (size_t)(BK * 2);
    const size_t hstepA = (size_t)64 * g.lda * 2, kstepA = (size_t)g.kstepA;
    const size_t hstepB = (size_t)(Epi::HEADPERM ? 32 : 128) * K * 2;
    const size_t tstep = (size_t)256 * K * 2;
    const unsigned ldsw = (unsigned)wid * 1024u;
    const unsigned lds_u32 = (unsigned)(size_t)lds;
    const int aoff = lds_byte(wr * 64 + fr, fq * 8), boff = lds_byte(wc * 32 + fr, fq * 8);
#define PG8_SA(b, h) (((b) * 2 + (h)) * HTB)
#define PG8_SB(b, h) ((4 + (b) * 2 + (h)) * HTB)
#define PG8_STAGE(bufoff, gbase, voff) do { _Pragma("unroll") for (int _i = 0; _i < 2; ++_i) { unsigned _keep; \
        const unsigned _ld = (unsigned)__builtin_amdgcn_readfirstlane((int)(lds_u32 + (unsigned)(bufoff) + ldsw + (unsigned)(_i * 8192))); \
        asm volatile("s_mov_b32 %0, m0\n\ts_mov_b32 m0, %2\n\ts_nop 0\n\tglobal_load_lds_dwordx4 %1, %3\n\ts_mov_b32 m0, %0" \
                     : "=&s"(_keep) : "v"((voff)[_i]), "s"(_ld), "s"((const char*)(gbase)) : "memory"); } } while (0)
#define PG8_LDA(dst, b, h) do { _Pragma("unroll") for (int m = 0; m < 4; ++m) _Pragma("unroll") for (int k = 0; k < 2; ++k) dst[m][k] = *(const LAS bf16x8*)(lds + PG8_SA(b, h) + aoff + m * 2048 + k * 1024); } while (0)
#define PG8_LDB(dst, b, h) do { _Pragma("unroll") for (int n = 0; n < 2; ++n) _Pragma("unroll") for (int k = 0; k < 2; ++k) dst[n][k] = *(const LAS bf16x8*)(lds + PG8_SB(b, h) + boff + n * 2048 + k * 1024); } while (0)
#define PG8_MMA(ai, bj, At, Bt) do { __builtin_amdgcn_s_setprio(1); _Pragma("unroll") for (int m = 0; m < 4; ++m) _Pragma("unroll") for (int n = 0; n < 2; ++n) _Pragma("unroll") for (int k = 0; k < 2; ++k) \
        acc[ai][bj][m][n] = __builtin_amdgcn_mfma_f32_16x16x32_bf16(Bt[n][k], At[m][k], acc[ai][bj][m][n], 0, 0, 0); __builtin_amdgcn_s_setprio(0); } while (0)
#define PG8_WAIT_V(n) asm volatile("s_waitcnt vmcnt(" #n ")" ::: "memory")
#define PG8_WAIT_L(n) asm volatile("s_waitcnt lgkmcnt(" #n ")" ::: "memory")
#define PG8_BAR __builtin_amdgcn_s_barrier()
#define PG8_SCHED __builtin_amdgcn_sched_barrier(0)
    Unit cur, nxt; int ui = 0;
    if (!S.next(0, cur)) return;
    f32x4 acc[2][2][4][2];
#pragma unroll
    for (int a = 0; a < 2; ++a)
#pragma unroll
        for (int b = 0; b < 2; ++b)
#pragma unroll
            for (int m = 0; m < 4; ++m)
#pragma unroll
                for (int n = 0; n < 2; ++n) acc[a][b][m][n] = (f32x4){0.f, 0.f, 0.f, 0.f};
    bf16x8 At[4][2], B0[2][2], B1[2][2];
    const char* cA = (const char*)g.A + (size_t)cur.pm * tstep; const char* cB = (const char*)g.Bt + (size_t)cur.pn * tstep;
    if (!b_prestaged) { PG8_STAGE(PG8_SB(0, 0), cB, voffB); PG8_STAGE(PG8_SB(0, 1), cB + hstepB, voffB); }
    PG8_STAGE(PG8_SA(0, 0), cA, voffA); PG8_STAGE(PG8_SA(0, 1), cA + hstepA, voffA);
    if (wr == 1) PG8_BAR;
    PG8_WAIT_V(2); PG8_BAR;
    PG8_STAGE(PG8_SB(1, 0), cB + kstep, voffB); PG8_STAGE(PG8_SA(1, 0), cA + kstepA, voffA); PG8_STAGE(PG8_SB(1, 1), cB + hstepB + kstep, voffB);
    PG8_WAIT_V(6); PG8_BAR;
    for (;;) {
        const bool has_next = S.next(ui + 1, nxt);
        const char* nA = has_next ? (const char*)g.A + (size_t)nxt.pm * tstep : cA; const char* nB = has_next ? (const char*)g.Bt + (size_t)nxt.pn * tstep : cB;
        for (int t = 0; t < nt; t += 2) {
            const bool last = (t == nt - 2);
            if constexpr (Epi::MID) { if (t == nt / 2) E.mid(acc, cur, wr, wc, fr, fq); }
            const char* a1 = cA + (size_t)(t + 1) * kstepA;
            const char* a2 = last ? nA : cA + (size_t)(t + 2) * kstepA; const char* b2 = last ? nB : cB + (size_t)(t + 2) * kstep;
            const char* a3 = a2 + kstepA; const char* b3 = b2 + kstep;
            PG8_LDB(B0, 0, 0); PG8_LDB(B1, 0, 1); PG8_SCHED; PG8_LDA(At, 0, 0); PG8_STAGE(PG8_SA(1, 1), a1 + hstepA, voffA);
            PG8_WAIT_V(8); PG8_WAIT_L(0); PG8_BAR; PG8_MMA(0, 0, At, B0); PG8_MMA(0, 1, At, B1); PG8_BAR; PG8_SCHED;
            PG8_LDA(At, 0, 1); PG8_STAGE(PG8_SB(0, 0), b2, voffB); PG8_STAGE(PG8_SB(0, 1), b2 + hstepB, voffB); PG8_STAGE(PG8_SA(0, 0), a2, voffA);
            PG8_WAIT_V(8); PG8_WAIT_L(0); PG8_BAR; PG8_MMA(1, 0, At, B0); PG8_MMA(1, 1, At, B1); PG8_BAR; PG8_SCHED;
            PG8_LDB(B0, 1, 0); PG8_LDB(B1, 1, 1); PG8_SCHED; PG8_LDA(At, 1, 0); PG8_STAGE(PG8_SA(0, 1), a2 + hstepA, voffA);
            PG8_WAIT_V(8); PG8_WAIT_L(0); PG8_BAR; PG8_MMA(0, 0, At, B0); PG8_MMA(0, 1, At, B1); PG8_BAR; PG8_SCHED;
            PG8_LDA(At, 1, 1); PG8_STAGE(PG8_SB(1, 0), b3, voffB); PG8_STAGE(PG8_SB(1, 1), b3 + hstepB, voffB); PG8_STAGE(PG8_SA(1, 0), a3, voffA);
            PG8_WAIT_V(8); PG8_WAIT_L(0); PG8_BAR; PG8_MMA(1, 0, At, B0); PG8_MMA(1, 1, At, B1); PG8_BAR; PG8_SCHED;
        }
        if (wr == 0) PG8_BAR;
        E(acc, cur, wr, wc, fr, fq);
        if (!has_next) break;
#pragma unroll
        for (int a = 0; a < 2; ++a)
#pragma unroll
            for (int b = 0; b < 2; ++b)
#pragma unroll
                for (int m = 0; m < 4; ++m)
#pragma unroll
                    for (int n = 0; n < 2; ++n) acc[a][b][m][n] = (f32x4){0.f, 0.f, 0.f, 0.f};
        cur = nxt; cA = nA; cB = nB; ++ui;
        if (wr == 1) PG8_BAR;
    }
    PG8_WAIT_V(0);
    PG8_BAR;
#undef PG8_SA
#undef PG8_SB
#undef PG8_STAGE
#undef PG8_LDA
#undef PG8_LDB
#undef PG8_MMA
#undef PG8_WAIT_V
#undef PG8_WAIT_L
#undef PG8_BAR
#undef PG8_SCHED
}
}

constexpr size_t MiB = 1u << 20;
constexpr size_t WS_WIN = 1 * MiB, WS_WOUT = 6 * MiB, WS_W1 = 8 * MiB, WS_W2 = 16 * MiB;
constexpr size_t WS_WSB = 27 * MiB;
constexpr size_t WS_SSQA = 26 * MiB;
constexpr size_t WS_SSQ = 24 * MiB;
constexpr size_t WS_XB = 32 * MiB;
constexpr size_t WS_Q = 96 * MiB, WS_K = 128 * MiB, WS_V = 160 * MiB, WS_U = 192 * MiB, WS_G = 224 * MiB, WS_MIX = 256 * MiB;
constexpr size_t WS_H = 96 * MiB;
constexpr size_t WS_END = 352 * MiB;
constexpr int LDS_BYTES = 157696, LDS_MISC = LDS_BYTES - 64;
constexpr size_t WS_CTL = 0, CTL_ZERO_BYTES = 16384;
constexpr int LDS_TT_PITCH = 272;
constexpr int LDS_SSQG = 4 * 128 * LDS_TT_PITCH;
constexpr int LDS_GG = LDS_SSQG + 2048;
constexpr int LDS_ATAB = 147456;
static_assert(LDS_ATAB + 64 * 144 <= LDS_BYTES - 64, "LDS map");

struct Args { const float* in[15]; float* out; unsigned char* ws; };

__device__ __forceinline__ void p0_transpose_item(const float* W, int K, int N, bf16_t* WT, const float* kscale, int klim, LAS float* scr, int item, int lane) {
    const int nblk = N / 32, kb = item / nblk, nb = item % nblk, k0 = 64 * kb, n0 = 32 * nb;
    float wv[32];
#pragma unroll
    for (int i = 0; i < 32; ++i) wv[i] = W[(size_t)(k0 + 2 * i + (lane >> 5)) * N + n0 + (lane & 31)];
#pragma unroll
    for (int i = 0; i < 32; ++i) { const int kk = 2 * i + (lane >> 5); float w = wv[i]; if (kscale && k0 + kk < klim) w *= kscale[k0 + kk]; scr[kk * 33 + (lane & 31)] = w; }
    asm volatile("s_waitcnt lgkmcnt(0)" ::: "memory");
    const int c = lane & 7;
#pragma unroll
    for (int j = 0; j < 4; ++j) { const int n = (lane >> 3) + 8 * j; const LAS float* s = scr + (8 * c) * 33 + n;
        u32x4 o; o.x = pk2(s[0 * 33], s[1 * 33]); o.y = pk2(s[2 * 33], s[3 * 33]); o.z = pk2(s[4 * 33], s[5 * 33]); o.w = pk2(s[6 * 33], s[7 * 33]);
        *(u32x4*)(WT + (size_t)(n0 + n) * K + k0 + 8 * c) = o; }
    asm volatile("s_waitcnt lgkmcnt(0)" ::: "memory");
}
__device__ __forceinline__ void rms_rows4_to_bf16(const float* x, const float* gain, bf16_t* o, size_t m0, size_t stride, int lane) {
    f32x4 v[4][4];
#pragma unroll
    for (int r = 0; r < 4; ++r) { const f32x4* xr = (const f32x4*)(x + (m0 + r * stride) * DM) + lane;
#pragma unroll
        for (int j = 0; j < 4; ++j) v[r][j] = xr[64 * j]; }
    f32x4 gr[4];
#pragma unroll
    for (int j = 0; j < 4; ++j) gr[j] = ((const f32x4*)gain + lane)[64 * j];
#pragma unroll
    for (int r = 0; r < 4; ++r) {
        float s = 0.f;
#pragma unroll
        for (int j = 0; j < 4; ++j) s += (v[r][j][0] * v[r][j][0] + v[r][j][1] * v[r][j][1]) + (v[r][j][2] * v[r][j][2] + v[r][j][3] * v[r][j][3]);
        const float rstd = rsqrtf(wave_sum(s) * (1.f / DM) + EPS);
        u32x2* o8 = (u32x2*)(o + (m0 + r * stride) * DM) + lane;
#pragma unroll
        for (int j = 0; j < 4; ++j) { const f32x4 y = v[r][j] * rstd * gr[j]; u32x2 w; w.x = pk2(y[0], y[1]); w.y = pk2(y[2], y[3]); o8[64 * j] = w; }
    }
}

constexpr int KC_PITCH = 160, LDS_KC = 0, LDS_VC = 16 * 32 * KC_PITCH;
static_assert(LDS_VC + 65536 <= LDS_ATAB, "attention LDS: K image | V image | multiplicity tables (the gMLP scratch overlays the images: different units, barrier-separated)");
__device__ __forceinline__ void run_desc(int tt, int g, int c, int R0, int& cg, int& Rg) {
    if (tt < 4) { cg = c; Rg = R0 - 16 + 4 * tt + g; }
    else if (tt < 7) { cg = (c + 4 * (tt - 3)) & 15; Rg = R0 - 4 + g; }
    else if (tt < 10) { const int o = 4 * (tt - 7) + g; const int o3 = (o * 11) >> 5; cg = (c + 1 + o3 * 4 + (o - 3 * o3)) & 15; Rg = R0 - 1; }
    else { cg = tt - 10; Rg = R0 + g; }
}
__device__ __forceinline__ bool tile_valid(int tt, int R0) {
    if (tt < 4) return R0 - 16 + 4 * tt >= 0;
    if (tt < 7) return R0 >= 4;
    if (tt < 10) return R0 >= 1;
    return true;
}
__device__ __forceinline__ int next_tile(int tt, int R0) { while (tt < 26 && !tile_valid(tt, R0)) ++tt; return tt; }

struct AttnP { const bf16_t *Q, *K, *Vt; bf16_t* MIX; float* ssqA; const float *gq, *gk; };

__device__ __forceinline__ void attn_load_k(const AttnP& P, LAS unsigned char* lds, int hb, int tt, int c, int R0, int lane, bf16x8 (&kf)[4]) {
    const int rho = lane & 31, h = lane >> 5;
    const int gk_ = 2 * (rho >> 4) + ((rho >> 2) & 1), pk_ = 4 * ((rho >> 3) & 1) + (rho & 3);
    if (tt < 10) {
        int cg, Rg; run_desc(tt, gk_, c, R0, cg, Rg);
        const bf16_t* kp = P.K + ((size_t)(hb * 16 + cg) * 128 + 8 * Rg + pk_) * 64 + 8 * h;
#pragma unroll
        for (int kk = 0; kk < 4; ++kk) kf[kk] = *(const bf16x8*)(kp + 16 * kk);
    } else {
        const LAS unsigned char* kp = lds + LDS_KC + ((tt - 10) * 32 + 8 * gk_ + pk_) * KC_PITCH + 16 * h;
#pragma unroll
        for (int kk = 0; kk < 4; ++kk) kf[kk] = *(const LAS bf16x8*)(kp + 32 * kk);
    }
}
__device__ __forceinline__ void attn_load_v(const AttnP& P, LAS unsigned char* lds, int hb, int tt, int c, int R0, int lane, bf16x8 (&vf)[2][2]) {
    const int rho = lane & 31, h = lane >> 5;
    if (tt < 10) {
#pragma unroll
        for (int s = 0; s < 2; ++s) { int cg, Rg; run_desc(tt, 2 * s + h, c, R0, cg, Rg);
            const bf16_t* vp = P.Vt + ((size_t)((hb * 16 + cg) * 16 + Rg) * 64 + rho) * 8;
            vf[0][s] = *(const bf16x8*)(vp); vf[1][s] = *(const bf16x8*)(vp + 32 * 8); }
    } else {
#pragma unroll
        for (int s = 0; s < 2; ++s) { const LAS unsigned char* vp = lds + LDS_VC + (((tt - 10) * 4 + 2 * s + h) * 64 + rho) * 16;
            vf[0][s] = *(const LAS bf16x8*)(vp); vf[1][s] = *(const LAS bf16x8*)(vp + 512); }
    }
}

__device__ __forceinline__ unsigned long long mult_bytes(int D0, int T2, int T3) {
    const unsigned long long ONES = 0x0101010101010101ull;
    const int l1 = max((D0 - 128 + 15) >> 4, 0), l2 = max((D0 - T2 + 15) >> 4, 0), l3 = max((D0 - T3 + 15) >> 4, 0);
    const unsigned long long w = (l1 >= 8 ? 0ull : (ONES << (8 * l1))) + (l2 >= 8 ? 0ull : (ONES << (8 * l2))) + (l3 >= 8 ? 0ull : (ONES << (8 * l3)));
    const int hi = D0 >> 4;
    const unsigned long long mh = hi < 0 ? 0ull : (hi >= 7 ? ~0ull : ((1ull << (8 * (hi + 1))) - 1ull));
    return w & mh;
}

__device__ __forceinline__ void attn_tables(int lane, unsigned long long (&T)[18]) {
    const int q = lane & 31, h = lane >> 5;
#pragma unroll
    for (int eg = 0; eg < 2; ++eg) { const int u16 = 16 * (q - 8 * (2 * eg + h)), g = 2 * eg + h;
        T[0 + eg] = mult_bytes(u16 + 1, 4096, -1) - mult_bytes(u16 + 1, -1, -1);
        T[2 + eg] = mult_bytes(u16 - 1, 4096, -1) - mult_bytes(u16 - 1, -1, -1);
        T[4 + eg] = mult_bytes(u16 + 1, -1, -1); T[6 + eg] = mult_bytes(u16 - 1, -1, -1);
        T[8 + eg] = mult_bytes(16 * (q + 128 - 8 * g), 512, 2048); T[10 + eg] = mult_bytes(16 * (q + 32 - 8 * g), 512, 2048);
        T[12 + eg] = mult_bytes(4 + 16 * (q + 32 - 8 * g), 512, -1); T[14 + eg] = mult_bytes(-4 + 16 * (q + 32 - 8 * g), 512, -1); }
    T[16] = mult_bytes(1 + 16 * (q + 8), -1, -1); T[17] = mult_bytes(-1 + 16 * (q + 8), -1, -1);
}

__device__ __forceinline__ void tile_compute(const bf16x8 (&kf)[4], const bf16x8 (&vf)[2][2], const bf16x8 (&qf)[4], unsigned long long w0, unsigned long long w1,
                                             float shift, f32x16& o0, f32x16& o1, f32x16& zacc) {
    f32x16 st = {};
#pragma unroll
    for (int kk = 0; kk < 4; ++kk) st = __builtin_amdgcn_mfma_f32_32x32x16_bf16(kf[kk], qf[kk], st, 0, 0, 0);
    if (__builtin_amdgcn_readfirstlane(__builtin_bit_cast(int, shift)) != 0) {
        asm volatile("" ::: "memory");
#pragma unroll
        for (int e = 0; e < 16; ++e) st[e] -= shift;
    }
    unsigned pw[8];
#pragma unroll
    for (int eg = 0; eg < 2; ++eg) {
        const unsigned long long w = eg ? w1 : w0;
        const unsigned wl = (unsigned)w, wh = (unsigned)(w >> 32);
        float pv[8];
#pragma unroll
        for (int p = 0; p < 4; ++p) {
            pv[p] = (float)((wl >> (8 * p)) & 0xffu) * __builtin_amdgcn_exp2f(st[8 * eg + p]);
            pv[4 + p] = (float)((wh >> (8 * p)) & 0xffu) * __builtin_amdgcn_exp2f(st[8 * eg + 4 + p]);
        }
#pragma unroll
        for (int p = 0; p < 4; ++p) pw[4 * eg + p] = pk2(pv[2 * p], pv[2 * p + 1]);
    }
    const bf16x8 ones = {0x3F80, 0x3F80, 0x3F80, 0x3F80, 0x3F80, 0x3F80, 0x3F80, 0x3F80};
    const bf16x8 pf0 = __builtin_bit_cast(bf16x8, (u32x4){pw[0], pw[1], pw[2], pw[3]});
    const bf16x8 pf1 = __builtin_bit_cast(bf16x8, (u32x4){pw[4], pw[5], pw[6], pw[7]});
    o0 = __builtin_amdgcn_mfma_f32_32x32x16_bf16(vf[0][0], pf0, o0, 0, 0, 0);
    o1 = __builtin_amdgcn_mfma_f32_32x32x16_bf16(vf[1][0], pf0, o1, 0, 0, 0);
    zacc = __builtin_amdgcn_mfma_f32_32x32x16_bf16(ones, pf0, zacc, 0, 0, 0);
    o0 = __builtin_amdgcn_mfma_f32_32x32x16_bf16(vf[0][1], pf1, o0, 0, 0, 0);
    o1 = __builtin_amdgcn_mfma_f32_32x32x16_bf16(vf[1][1], pf1, o1, 0, 0, 0);
    zacc = __builtin_amdgcn_mfma_f32_32x32x16_bf16(ones, pf1, zacc, 0, 0, 0);
}

__device__ __forceinline__ void attn_task(const AttnP& P, LAS unsigned char* lds, int b, int hd, int qq, int c, float shift, int lane_in) {
    int lane = lane_in; asm volatile("" : "+v"(lane));
    const int hb = b * 8 + hd, q = lane & 31, h = lane >> 5, R0 = 4 * qq, iq0 = 32 * qq;
    bf16x8 qf[4];
    { const bf16_t* qp = P.Q + ((size_t)(hb * 16 + c) * 128 + iq0 + q) * 64 + 8 * h;
#pragma unroll
      for (int kk = 0; kk < 4; ++kk) qf[kk] = *(const bf16x8*)(qp + 16 * kk); }
    bf16x8 gk[4];
    int gi = next_tile(0, R0);
    if (gi < 10) attn_load_k(P, lds, hb, gi, c, R0, lane, gk);
    unsigned long long Hp[2], Hn[2], Bp[2], Bn[2], mT0[2], mT3[2], mAp[2], mAn[2], mLp, mLn;
    { const LAS unsigned long long* T = (const LAS unsigned long long*)(lds + LDS_ATAB + lane * 144);
      Hp[0] = T[0]; Hp[1] = T[1]; Hn[0] = T[2]; Hn[1] = T[3]; Bp[0] = T[4]; Bp[1] = T[5]; Bn[0] = T[6]; Bn[1] = T[7];
      mT0[0] = T[8]; mT0[1] = T[9]; mT3[0] = T[10]; mT3[1] = T[11]; mAp[0] = T[12]; mAp[1] = T[13]; mAn[0] = T[14]; mAn[1] = T[15]; mLp = T[16]; mLn = T[17]; }
    f32x16 o0 = {}, o1 = {}, zacc = {};
    int li = 10, ph = 0;
#pragma clang loop unroll(disable)
    while (li < 26 || gi < 10) {
        bf16x8 kf[4], vf[2][2];
        unsigned long long w0, w1;
        if (gi < 10 && (ph >= 2 || li >= 26)) {
            attn_load_v(P, lds, hb, gi, c, R0, lane, vf);
#pragma unroll
            for (int kk = 0; kk < 4; ++kk) kf[kk] = gk[kk];
            if (gi < 4) {
                if (gi == 0) { w0 = mT0[0]; w1 = mT0[1]; } else if (gi == 3) { w0 = mT3[0]; w1 = mT3[1]; } else { w0 = 0x0101010101010101ull; w1 = 0x0101010101010101ull; }
            } else if (gi < 7) {
                const bool pos = c > ((c + 4 * (gi - 3)) & 15);
                w0 = pos ? mAp[0] : mAn[0]; w1 = pos ? mAp[1] : mAn[1];
            } else {
                { int cg, Rg; run_desc(gi, h, c, R0, cg, Rg); w0 = (c > cg) ? mLp : mLn; }
                { int cg, Rg; run_desc(gi, 2 + h, c, R0, cg, Rg); w1 = (c > cg) ? mLp : mLn; }
            }
            gi = next_tile(gi + 1, R0);
            if (gi < 10) attn_load_k(P, lds, hb, gi, c, R0, lane, gk);
            ph = 0;
        } else {
            attn_load_k(P, lds, hb, li, c, R0, lane, kf); attn_load_v(P, lds, hb, li, c, R0, lane, vf);
            const int dl = c - (li - 10);
            if (dl == 0) { w0 = 3 * Hp[0] - Hn[0] + Bn[0]; w1 = 3 * Hp[1] - Hn[1] + Bn[1]; }
            else if (dl > 0) { const unsigned long long m = ((dl & 3) == 0) ? ~0ull : 0ull; w0 = Bp[0] + (Hp[0] & m); w1 = Bp[1] + (Hp[1] & m); }
            else { const unsigned long long m = ((dl & 3) == 0) ? ~0ull : 0ull; w0 = Bn[0] + (Hn[0] & m); w1 = Bn[1] + (Hn[1] & m); }
            ++li; ++ph;
        }
        tile_compute(kf, vf, qf, w0, w1, shift, o0, o1, zacc);
    }
    const float rz = 1.0f / zacc[0];
    float ss = 0.f;
#pragma unroll
    for (int e = 0; e < 16; ++e) { o0[e] *= rz; o1[e] *= rz; ss += o0[e] * o0[e] + o1[e] * o1[e]; }
    ss = xor32_sum(ss);
    const size_t tok = (size_t)b * SEQ + c + 16 * (iq0 + q);
    if (h == 0) P.ssqA[tok * 8 + hd] = ss;
    bf16_t* orow = P.MIX + tok * DM + hd * 64;
#pragma unroll
    for (int e4 = 0; e4 < 4; ++e4) {
        const int d0 = 8 * e4 + 4 * h;
        u32x2 w0, w1;
        w0.x = pk2(o0[4 * e4], o0[4 * e4 + 1]); w0.y = pk2(o0[4 * e4 + 2], o0[4 * e4 + 3]);
        w1.x = pk2(o1[4 * e4], o1[4 * e4 + 1]); w1.y = pk2(o1[4 * e4 + 2], o1[4 * e4 + 3]);
        *(u32x2*)(orow + d0) = w0; *(u32x2*)(orow + 32 + d0) = w1;
    }
}

__device__ __forceinline__ void attn_unit(const AttnP& P, LAS unsigned char* lds, int b, int hd, int qq, int wave, int lane) {
    int tid_ = threadIdx.x; asm volatile("" : "+v"(tid_));
    const int hb = b * 8 + hd, tid = tid_;
    float shift;
    { const float mq = wave_max(fabsf(P.gq[lane])), mk = wave_max(fabsf(P.gk[lane])); shift = fminf(8.0f * mq * mk * 1.4426950408889634f, 64.0f); shift = shift > 30.0f ? shift : 0.f; }
    {
        u32x4 kr[8], vr[8];
#pragma unroll
        for (int j = 0; j < 8; ++j) { const int chunk = tid + 512 * j, row = chunk >> 3, piece = chunk & 7, cls = row >> 5, il = row & 31;
            kr[j] = *(const u32x4*)(P.K + ((size_t)(hb * 16 + cls) * 128 + 32 * qq + il) * 64 + piece * 8); }
#pragma unroll
        for (int j = 0; j < 8; ++j) { const int chunk = tid + 512 * j, cls = chunk >> 8, within = chunk & 255;
            vr[j] = *(const u32x4*)(P.Vt + ((size_t)(hb * 16 + cls) * 16 + 4 * qq) * 512 + within * 8); }
        __syncthreads();
#pragma unroll
        for (int j = 0; j < 8; ++j) { const int chunk = tid + 512 * j, row = chunk >> 3, piece = chunk & 7;
            *(LAS u32x4*)(lds + LDS_KC + row * KC_PITCH + piece * 16) = kr[j]; }
#pragma unroll
        for (int j = 0; j < 8; ++j) { const int chunk = tid + 512 * j; *(LAS u32x4*)(lds + LDS_VC + chunk * 16) = vr[j]; }
    }
    __syncthreads();
    attn_task(P, lds, b, hd, qq, wave, shift, lane);
    attn_task(P, lds, b, hd, qq, wave + 8, shift, lane);
}

struct GmlpP { const bf16_t *U, *G; bf16_t* MIX; const float *lng, *lnb; const bf16_t* wsb; const float *bs, *go; };
__device__ __forceinline__ void gmlp_unit(const GmlpP& P, int b, int ch, LAS unsigned char* lds, int wave, int lane_in) {
    int lane = lane_in; asm volatile("" : "+v"(lane));
    const size_t tok0 = (size_t)b * SEQ + (size_t)ch * 128;
    const int gI = wave >> 1, th = wave & 1;
    {
        const int sub = lane & 15, rr = lane >> 4;
        const f32x4 ga0 = *(const f32x4*)(P.lng + gI * 128 + 8 * sub), ga1 = *(const f32x4*)(P.lng + gI * 128 + 8 * sub + 4);
        const f32x4 be0 = *(const f32x4*)(P.lnb + gI * 128 + 8 * sub), be1 = *(const f32x4*)(P.lnb + gI * 128 + 8 * sub + 4);
        u32x4 rawv[16];
#pragma unroll
        for (int it = 0; it < 16; ++it) rawv[it] = *(const u32x4*)(P.G + (tok0 + 64 * th + 16 * rr + it) * GW + gI * 128 + 8 * sub);
        const f32x4 gstage = (threadIdx.x < 128) ? *(const f32x4*)(P.go + (threadIdx.x & 127) * 4) : (f32x4){0.f, 0.f, 0.f, 0.f};
        __syncthreads();
        if (threadIdx.x < 128) *(LAS f32x4*)(lds + LDS_GG + threadIdx.x * 16) = gstage;
#pragma unroll
        for (int hf = 0; hf < 2; ++hf) {
            float yv[8][8];
#pragma unroll
            for (int i = 0; i < 8; ++i) {
                const u32x4 raw = rawv[8 * hf + i];
                float v[8];
#pragma unroll
                for (int j = 0; j < 4; ++j) { v[2 * j] = __builtin_bit_cast(float, raw[j] << 16); v[2 * j + 1] = __builtin_bit_cast(float, raw[j] & 0xffff0000u); }
                float sm = 0.f;
#pragma unroll
                for (int j = 0; j < 8; ++j) sm += v[j];
                sm = row16_sum(sm);
                const float mu = sm * (1.0f / 128.0f);
                float sq = 0.f;
#pragma unroll
                for (int j = 0; j < 8; ++j) { v[j] -= mu; sq += v[j] * v[j]; }
                sq = row16_sum(sq);
                const float rs = rsqrtf(sq * (1.0f / 128.0f) + EPS);
#pragma unroll
                for (int j = 0; j < 8; ++j) yv[j][i] = v[j] * rs * (j < 4 ? ga0[j & 3] : ga1[j & 3]) + (j < 4 ? be0[j & 3] : be1[j & 3]);
            }
            const int s0 = 64 * th + 16 * rr + 8 * hf;
            LAS unsigned char* dst = lds + (gI * 128 + 8 * sub) * LDS_TT_PITCH + 16 * ((s0 >> 3) ^ sub);
#pragma unroll
            for (int j = 0; j < 8; ++j) {
                u32x4 w; w.x = pk2(yv[j][0], yv[j][1]); w.y = pk2(yv[j][2], yv[j][3]); w.z = pk2(yv[j][4], yv[j][5]); w.w = pk2(yv[j][6], yv[j][7]);
                *(LAS u32x4*)(dst + j * LDS_TT_PITCH) = w;
            }
            asm volatile("" ::: "memory");
        }
    }
    const int r32 = lane & 31, h = lane >> 5;
    const int tt0 = th, tt1 = 3 - th;
    bf16x8 bw0[4], bw1[8];
    { const bf16_t* w0p = P.wsb + ((size_t)(gI * 128 + 32 * tt0 + r32) * 128 + 8 * h);
      const bf16_t* w1p = P.wsb + ((size_t)(gI * 128 + 32 * tt1 + r32) * 128 + 8 * h);
#pragma unroll
      for (int ks = 0; ks < 4; ++ks) bw0[ks] = *(const bf16x8*)(w0p + 16 * ks);
#pragma unroll
      for (int ks = 0; ks < 8; ++ks) bw1[ks] = *(const bf16x8*)(w1p + 16 * ks); }
    __syncthreads();
    f32x16 acc[4][2];
#pragma unroll
    for (int mt = 0; mt < 4; ++mt) { acc[mt][0] = (f32x16){}; acc[mt][1] = (f32x16){}; }
    {
#pragma unroll
        for (int ks = 0; ks < 8; ++ks)
#pragma unroll
            for (int mt = 0; mt < 4; ++mt) {
                const int cc = 32 * mt + r32;
                const bf16x8 a = *(const LAS bf16x8*)(lds + (gI * 128 + cc) * LDS_TT_PITCH + 16 * ((2 * ks + h) ^ ((cc >> 3) & 15)));
                if (ks < 4) acc[mt][0] = __builtin_amdgcn_mfma_f32_32x32x16_bf16(a, bw0[ks], acc[mt][0], 0, 0, 0);
                acc[mt][1] = __builtin_amdgcn_mfma_f32_32x32x16_bf16(a, bw1[ks], acc[mt][1], 0, 0, 0);
                if (mt == 3 && (ks & 1)) asm volatile("" ::: "memory");
            }
    }
    LAS float* ssqg = (LAS float*)(lds + LDS_SSQG);
#pragma unroll
    for (int nt = 0; nt < 2; ++nt) {
        const int t = 32 * (nt == 0 ? tt0 : tt1) + r32;
        const float bsv = P.bs[gI * 128 + t];
        const bf16_t* up = P.U + (tok0 + t) * GW + gI * 128 + 4 * h;
        float ss = 0.f;
        u32x2 uraw[4][4];
#pragma unroll
        for (int mt = 0; mt < 4; ++mt)
#pragma unroll
            for (int e4 = 0; e4 < 4; ++e4) uraw[mt][e4] = *(const u32x2*)(up + 32 * mt + 8 * e4);
#pragma unroll
        for (int mt = 0; mt < 4; ++mt)
#pragma unroll
            for (int e4 = 0; e4 < 4; ++e4) {
                const u32x2 raw = uraw[mt][e4];
                const float u0 = __builtin_bit_cast(float, raw.x << 16), u1 = __builtin_bit_cast(float, raw.x & 0xffff0000u);
                const float u2 = __builtin_bit_cast(float, raw.y << 16), u3 = __builtin_bit_cast(float, raw.y & 0xffff0000u);
                float m0 = u0 * (acc[mt][nt][4 * e4] + bsv), m1 = u1 * (acc[mt][nt][4 * e4 + 1] + bsv), m2 = u2 * (acc[mt][nt][4 * e4 + 2] + bsv), m3 = u3 * (acc[mt][nt][4 * e4 + 3] + bsv);
                acc[mt][nt][4 * e4] = m0; acc[mt][nt][4 * e4 + 1] = m1; acc[mt][nt][4 * e4 + 2] = m2; acc[mt][nt][4 * e4 + 3] = m3;
                ss += (m0 * m0 + m1 * m1) + (m2 * m2 + m3 * m3);
            }
        ss = xor32_sum(ss);
        if (h == 0) ssqg[gI * 128 + t] = ss;
    }
    __syncthreads();
#pragma unroll
    for (int nt = 0; nt < 2; ++nt) {
        const int t = 32 * (nt == 0 ? tt0 : tt1) + r32;
        const float tot = (ssqg[t] + ssqg[128 + t]) + (ssqg[256 + t] + ssqg[384 + t]);
        const float r = rsqrtf(tot * (1.0f / GW) + EPS);
        bf16_t* op = P.MIX + (tok0 + t) * DM + AW + gI * 128 + 4 * h;
#pragma unroll
        for (int mt = 0; mt < 4; ++mt)
#pragma unroll
            for (int e4 = 0; e4 < 4; ++e4) {
                const f32x4 gg = *(const LAS f32x4*)(lds + LDS_GG + (gI * 128 + 32 * mt + 8 * e4 + 4 * h) * 4);
                u32x2 w; w.x = pk2(acc[mt][nt][4 * e4] * r * gg[0], acc[mt][nt][4 * e4 + 1] * r * gg[1]); w.y = pk2(acc[mt][nt][4 * e4 + 2] * r * gg[2], acc[mt][nt][4 * e4 + 3] * r * gg[3]);
                *(u32x2*)(op + 32 * mt + 8 * e4) = w;
            }
    }
}

typedef __attribute__((address_space(1))) unsigned gu32;
#define XB_TMO      128
#define XB_XCNT(j)  (256  + 64 * (j))
#define XB_XSUB(j)  (1280 + 64 * (j))
#define XB_XGEN(j)  (2304 + 64 * (j))
#define XB_TOP      3328
#define XB_TOPGEN   3392
#define XCD_BAR_WORDS 3456
#define XB_SPIN_CAP (1u << 18)
__device__ __forceinline__ unsigned xb_ld(unsigned* p)              { return __hip_atomic_load(p, __ATOMIC_RELAXED, __HIP_MEMORY_SCOPE_AGENT); }
__device__ __forceinline__ unsigned xb_add(unsigned* p, unsigned v) { return __hip_atomic_fetch_add(p, v, __ATOMIC_RELAXED, __HIP_MEMORY_SCOPE_AGENT); }
__device__ __forceinline__ unsigned xb_xcc_id() { return (unsigned)__builtin_amdgcn_s_getreg((3 << 11) | 20) & 0xFu; }
#define XB_SPIN(cond, bar) do { unsigned _sp = 0; while (cond) { __builtin_amdgcn_s_sleep(1); \
    if ((++_sp & 255u) == 0u) { if (xb_ld(&(bar)[XB_TMO])) break; if (_sp > XB_SPIN_CAP) { atomicAdd(&(bar)[XB_TMO], 1u); break; } } } } while (0)
struct XcdBarrier { unsigned* bar; unsigned x; volatile LAS unsigned* st; };
__device__ __forceinline__ XcdBarrier xcd_barrier_post(unsigned* bar, volatile LAS unsigned* st) {
    XcdBarrier b; b.bar = bar; b.x = xb_xcc_id(); b.st = st;
    if (threadIdx.x == 0) (void)xb_add(&bar[XB_XCNT(b.x)], 1u);
    return b;
}
__device__ __forceinline__ void xcd_barrier_complete(unsigned* bar, unsigned x, unsigned& nloc, unsigned& nx) {
    const unsigned G = gridDim.x * gridDim.y * gridDim.z;
    unsigned sum, cnt, mine, sp = 0u;
    for (;;) {
        sum = 0u; cnt = 0u; mine = 0u;
#pragma unroll
        for (unsigned j = 0; j < 16; ++j) { const unsigned c = xb_ld(&bar[XB_XCNT(j)]); sum += c; cnt += (c > 0u) ? 1u : 0u; mine = (j == x) ? c : mine; }
        if (sum == G) break;
        __builtin_amdgcn_s_sleep(1);
        if ((++sp & 255u) == 0u) { if (xb_ld(&bar[XB_TMO])) break; if (sp > XB_SPIN_CAP) { atomicAdd(&bar[XB_TMO], 1u); break; } }
    }
    nloc = mine > 0u ? mine : 1u; nx = cnt > 0u ? cnt : 1u;
}
__device__ __forceinline__ void xcd_barrier(const XcdBarrier& b) {
    asm volatile("s_waitcnt vmcnt(0)" ::: "memory");
    __syncthreads();
    if (threadIdx.x == 0) {
        unsigned* bar = b.bar;
        __builtin_amdgcn_s_waitcnt(0);
        unsigned nloc = b.st[0], nx = b.st[1];
        if (nloc == 0u) { xcd_barrier_complete(bar, b.x, nloc, nx); b.st[0] = nloc; b.st[1] = nx; }
        const unsigned old = xb_add(&bar[XB_XSUB(b.x)], 1u);
        const unsigned gen = old / nloc;
        if (old + 1u == (gen + 1u) * nloc) {
            __builtin_amdgcn_fence(__ATOMIC_RELEASE, "agent");
            asm volatile("s_waitcnt vmcnt(0)" ::: "memory");
            const unsigned og = xb_add(&bar[XB_TOP], 1u);
            const unsigned tg = og / nx;
            if (og + 1u == (tg + 1u) * nx) xb_add(&bar[XB_TOPGEN], 1u);
            else XB_SPIN(xb_ld(&bar[XB_TOPGEN]) == tg, bar);
            __builtin_amdgcn_fence(__ATOMIC_ACQUIRE, "agent");
            xb_add(&bar[XB_XGEN(b.x)], 1u);
            asm volatile("s_waitcnt vmcnt(0)" ::: "memory");
        } else {
            XB_SPIN(xb_ld(&bar[XB_XGEN(b.x)]) == gen, bar);
            __builtin_amdgcn_fence(__ATOMIC_ACQUIRE, "agent");
            asm volatile("s_waitcnt vmcnt(0)" ::: "memory");
        }
    }
    __syncthreads();
}

#ifndef REP_P0
#define REP_P0 1
#endif
#ifndef REP_P1
#define REP_P1 1
#endif
#ifndef REP_P2
#define REP_P2 1
#endif
#ifndef REP_GM
#define REP_GM 1
#endif
#ifndef REP_P3
#define REP_P3 1
#endif
#ifndef REP_P4
#define REP_P4 1
#endif
__global__ void __launch_bounds__(512, 2) mk_fwd(Args args) {
    extern __shared__ __attribute__((aligned(16))) unsigned char lds_raw[];
    LAS unsigned char* lds = (LAS unsigned char*)lds_raw;
    const int tid = threadIdx.x, lane = tid & 63, wave = __builtin_amdgcn_readfirstlane(tid >> 6);
    const int G = gridDim.x, bx = blockIdx.x;
    unsigned char* ws = args.ws;
    const float* x = args.in[0]; const float* norm1_g = args.in[1]; const float* w_in = args.in[2]; const float* q_norm_g = args.in[3]; const float* k_norm_g = args.in[4];
    const float* ln_v_g = args.in[5]; const float* ln_v_b = args.in[6]; const float* w_sp = args.in[7]; const float* b_sp = args.in[8];
    const float* attn_out_g = args.in[9]; const float* gmlp_out_g = args.in[10]; const float* w_out = args.in[11]; const float* norm2_g = args.in[12];
    const float* w_ff1 = args.in[13]; const float* w_ff2 = args.in[14];
    float* out = args.out;
    bf16_t* Win_t = (bf16_t*)(ws + WS_WIN); bf16_t* Wout_t = (bf16_t*)(ws + WS_WOUT); bf16_t* W1_t = (bf16_t*)(ws + WS_W1); bf16_t* W2_t = (bf16_t*)(ws + WS_W2);
    float* ssq = (float*)(ws + WS_SSQ); float* ssqA = (float*)(ws + WS_SSQA); bf16_t* Wsb = (bf16_t*)(ws + WS_WSB);
    bf16_t* XB = (bf16_t*)(ws + WS_XB); bf16_t* Qb = (bf16_t*)(ws + WS_Q); bf16_t* Kb = (bf16_t*)(ws + WS_K); bf16_t* Vt = (bf16_t*)(ws + WS_V);
    bf16_t* Ub = (bf16_t*)(ws + WS_U); bf16_t* Gb = (bf16_t*)(ws + WS_G); bf16_t* MIX = (bf16_t*)(ws + WS_MIX); bf16_t* Hb = (bf16_t*)(ws + WS_H);

    volatile LAS unsigned* MISC = (volatile LAS unsigned*)(lds + LDS_MISC);
    if (tid < 16) MISC[tid] = 0u;
    __syncthreads();
    const XcdBarrier bar = xcd_barrier_post((unsigned*)(ws + WS_CTL), MISC);
#ifndef SKIP_P0
    {
        LAS float* scr = (LAS float*)(lds + wave * 16384);
        const int gw = bx * 8 + wave, NGW = G * 8;
        constexpr int I_IN = (DM / 64) * (NIN / 32), I_OUT = (DM / 64) * (DM / 32), I_1 = (DM / 64) * (FF / 32), I_2 = (FF / 64) * (DM / 32);
        constexpr int NITEMS = I_IN + I_OUT + I_1 + I_2;
        for (int it = gw; it < NITEMS; it += NGW) {
            int r = it;
            if (r < I_IN) { p0_transpose_item(w_in, DM, NIN, Win_t, nullptr, 0, scr, r, lane); continue; } r -= I_IN;
            if (r < I_OUT) { p0_transpose_item(w_out, DM, DM, Wout_t, attn_out_g, AW, scr, r, lane); continue; } r -= I_OUT;
            if (r < I_1) { p0_transpose_item(w_ff1, DM, FF, W1_t, norm2_g, DM, scr, r, lane); continue; } r -= I_1;
            p0_transpose_item(w_ff2, FF, DM, W2_t, nullptr, 0, scr, r, lane);
        }
        for (int e = (bx * 512 + tid) * 2; e < 4 * 128 * 128; e += G * 512 * 2) {
            const int tt_ = (e >> 7) & 127, ss_ = e & 127; const f32x2 wv = *(const f32x2*)(w_sp + e);
            *(unsigned*)(Wsb + e) = pk2(ss_ <= tt_ ? wv[0] : 0.f, ss_ + 1 <= tt_ ? wv[1] : 0.f); }
        int m = gw;
        for (; m + 3 * NGW < M; m += 4 * NGW) rms_rows4_to_bf16(x, norm1_g, XB, (size_t)m, (size_t)NGW, lane);
        for (; m < M; m += NGW) rms_rows4_to_bf16(x, norm1_g, XB, (size_t)m, 0, lane);
    }
#endif
    xcd_barrier(bar);
#ifndef SKIP_P1
    {
        pg8::Gemm g{XB, Win_t, M, NIN, DM, DM, 128}; pg8::StaticOrder S; S.init(M, NIN, G, bx, REP_P1);
        pg8::EpiIn E{Qb, Kb, Vt, Ub, Gb, q_norm_g, k_norm_g};
        pg8::gemm_phase<pg8::EpiIn, pg8::StaticOrder>(lds, g, S, E);
    }
#endif
    xcd_barrier(bar);
#ifndef SKIP_P2
    {
#ifndef SKIP_ATT
        const AttnP AP{Qb, Kb, Vt, MIX, ssqA, q_norm_g, k_norm_g};
        if (wave == 0) { unsigned long long T[18]; attn_tables(lane, T); LAS unsigned long long* D = (LAS unsigned long long*)(lds + LDS_ATAB + lane * 144);
#pragma unroll
            for (int k = 0; k < 18; ++k) D[k] = T[k]; }
        __syncthreads();
        for (int p = bx; p < 256 * REP_P2; p += G) { const int pp = p & 255, hd = pp & 7, qa = (pp >> 3) & 1, b = pp >> 4;
            attn_unit(AP, lds, b, hd, 3 - qa, wave, lane); attn_unit(AP, lds, b, hd, qa, wave, lane); }
#endif
#ifndef SKIP_GMLP
        const GmlpP GP{Ub, Gb, MIX, ln_v_g, ln_v_b, Wsb, b_sp, gmlp_out_g};
        for (int a = bx; a < 256 * REP_GM; a += G) gmlp_unit(GP, (a & 255) >> 4, a & 15, lds, wave, lane);
#endif
    }
#endif
    { pg8::Gemm g{MIX, Wout_t, M, DM, DM, DM, 128}; pg8::StaticOrder S; S.init(M, DM, G, bx, REP_P3); pg8::gemm_prestage_b<pg8::EpiOut, pg8::StaticOrder>(lds, g, S); }
    xcd_barrier(bar);
#ifndef SKIP_P3
    {
        pg8::Gemm g{MIX, Wout_t, M, DM, DM, DM, 128}; pg8::StaticOrder S; S.init(M, DM, G, bx, REP_P3);
        pg8::EpiOut E{x, XB, ssq, ssqA};
        pg8::gemm_phase<pg8::EpiOut, pg8::StaticOrder>(lds, g, S, E, true);
    }
#endif
    { pg8::Gemm g{XB, W1_t, M / 2, FF, DM, DM, 128}; pg8::StaticOrder S; S.init(M / 2, FF, G, bx, REP_P4, 0); pg8::gemm_prestage_b<pg8::EpiUp, pg8::StaticOrder>(lds, g, S); }
    xcd_barrier(bar);
#ifndef SKIP_P4
#pragma unroll 1
    for (int hf = 0; hf < 2; ++hf) {
        {
            pg8::Gemm g{XB, W1_t, M / 2, FF, DM, DM, 128}; pg8::StaticOrder S; S.init(M / 2, FF, G, bx, REP_P4, 64 * hf);
            pg8::EpiUp E{Hb, ssq};
            pg8::gemm_phase<pg8::EpiUp, pg8::StaticOrder>(lds, g, S, E, hf == 0);
        }
        { pg8::Gemm g{Hb, W2_t, M / 2, DM, FF, 64, 256 * 64 * 2}; pg8::StaticOrder S; S.init(M / 2, DM, G, bx, 1, 64 * hf); pg8::gemm_prestage_b<pg8::EpiDown, pg8::StaticOrder>(lds, g, S); }
        xcd_barrier(bar);
        {
            pg8::Gemm g{Hb, W2_t, M / 2, DM, FF, 64, 256 * 64 * 2}; pg8::StaticOrder S; S.init(M / 2, DM, G, bx, 1, 64 * hf);
            pg8::EpiDown E{out, XB};
            pg8::gemm_phase<pg8::EpiDown, pg8::StaticOrder>(lds, g, S, E, true);
        }
    }
#endif
}

extern "C" void kernel_launch(void* const* d_in, const int* in_sizes, int n_in, void* d_out, int out_size, void* d_ws, size_t ws_size, hipStream_t stream) {
    static int grid = 0;
    if (grid == 0) {
        if (n_in != 15 || in_sizes[0] != M * DM || out_size != M * DM || ws_size < WS_END) { fprintf(stderr, "kernel_launch: unexpected shapes (n_in %d, in0 %d, out %d, ws %zu)\n", n_in, n_in > 0 ? in_sizes[0] : -1, out_size, ws_size); grid = -1; return; }
        int dev = 0, cus = 0, per_cu = 0;
        if (hipGetDevice(&dev) != hipSuccess || hipDeviceGetAttribute(&cus, hipDeviceAttributeMultiprocessorCount, dev) != hipSuccess) { grid = -1; return; }
        if (hipFuncSetAttribute((const void*)mk_fwd, hipFuncAttributeMaxDynamicSharedMemorySize, LDS_BYTES) != hipSuccess) { fprintf(stderr, "kernel_launch: hipFuncSetAttribute failed\n"); grid = -1; return; }
        if (hipOccupancyMaxActiveBlocksPerMultiprocessor(&per_cu, (const void*)mk_fwd, 512, LDS_BYTES) != hipSuccess || per_cu < 1) { fprintf(stderr, "kernel_launch: occupancy query says %d blocks per CU\n", per_cu); (void)hipGetLastError(); per_cu = 1; }
        grid = cus;
    }
    if (grid < 0) return;
    Args a{};
    for (int i = 0; i < 15; ++i) a.in[i] = (const float*)d_in[i];
    a.out = (float*)d_out; a.ws = (unsigned char*)d_ws;
    if (hipMemsetAsync((char*)d_ws + WS_CTL, 0, CTL_ZERO_BYTES, stream) != hipSuccess) { fprintf(stderr, "kernel_launch: memset failed\n"); return; }
    void* kargs[] = {&a};
    const hipError_t e = hipLaunchCooperativeKernel((const void*)mk_fwd, dim3(grid), dim3(512), kargs, LDS_BYTES, stream);
    if (e != hipSuccess) fprintf(stderr, "kernel_launch: cooperative launch failed: %s (grid %d)\n", hipGetErrorString(e), grid);
}
```

```cpp
#include <hip/hip_runtime.h>
#include <hip/hip_cooperative_groups.h>
#include <cstdio>
#include <cstdint>
namespace cg = cooperative_groups;

#define LAS __attribute__((address_space(3)))
typedef unsigned short bf16_t;
typedef short bf16x8 __attribute__((ext_vector_type(8)));
typedef float f32x4 __attribute__((ext_vector_type(4)));
typedef float f32x2 __attribute__((ext_vector_type(2)));
typedef float f32x16 __attribute__((ext_vector_type(16)));
typedef unsigned u32x4 __attribute__((ext_vector_type(4)));
typedef unsigned u32x2 __attribute__((ext_vector_type(2)));
typedef __bf16 bf16x2_t __attribute__((ext_vector_type(2)));

constexpr int BATCH = 16, SEQ = 2048, DM = 1024, M = BATCH * SEQ;
constexpr int NH = 8, HD = 64, AW = 512, GW = 512, NIN = 2560, FF = 4096;
constexpr float EPS = 1e-6f;
constexpr float C2 = 0.125f * 1.4426950408889634f;

__device__ __forceinline__ unsigned pk2(float lo, float hi) { f32x2 v = {lo, hi}; bf16x2_t b = __builtin_convertvector(v, bf16x2_t); return __builtin_bit_cast(unsigned, b); }
__device__ __forceinline__ float bf2f(unsigned short b) { return __builtin_bit_cast(float, (unsigned)b << 16); }
__device__ __forceinline__ float gelu_t(float x) {
    const float t = x * (1.0f + 0.044715f * x * x) * (-2.0f * 0.7978845608028654f * 1.4426950408889634f);
    return x * __builtin_amdgcn_rcpf(1.0f + __builtin_amdgcn_exp2f(t));
}
__device__ __forceinline__ float row16_sum(float v) {
    v += __builtin_bit_cast(float, __builtin_amdgcn_update_dpp(0, __builtin_bit_cast(int, v), 0x128, 0xf, 0xf, true));
    v += __builtin_bit_cast(float, __builtin_amdgcn_update_dpp(0, __builtin_bit_cast(int, v), 0x124, 0xf, 0xf, true));
    v += __builtin_bit_cast(float, __builtin_amdgcn_update_dpp(0, __builtin_bit_cast(int, v), 0x4E, 0xf, 0xf, true));
    v += __builtin_bit_cast(float, __builtin_amdgcn_update_dpp(0, __builtin_bit_cast(int, v), 0xB1, 0xf, 0xf, true));
    return v;
}
__device__ __forceinline__ float xor16_32_sum(float v) {
    { const auto r = __builtin_amdgcn_permlane16_swap(__float_as_uint(v), __float_as_uint(v), false, false); v = __uint_as_float(r[0]) + __uint_as_float(r[1]); }
    { const auto r = __builtin_amdgcn_permlane32_swap(__float_as_uint(v), __float_as_uint(v), false, false); v = __uint_as_float(r[0]) + __uint_as_float(r[1]); }
    return v;
}
__device__ __forceinline__ float xor32_sum(float v) {
    const auto r = __builtin_amdgcn_permlane32_swap(__float_as_uint(v), __float_as_uint(v), false, false); return __uint_as_float(r[0]) + __uint_as_float(r[1]);
}
__device__ __forceinline__ float wave_sum(float v) { return xor16_32_sum(row16_sum(v)); }
__device__ __forceinline__ float wave_max(float v) {
#pragma unroll
    for (int o = 1; o < 64; o <<= 1) v = fmaxf(v, __shfl_xor(v, o));
    return v;
}

namespace pg8 {
constexpr int BM = 256, BK = 64, HALF = 128, HTB = HALF * BK * 2, STAGE_BYTES = 8 * HTB, NXCD = 8, WGM = 8;
__host__ __device__ __forceinline__ int lds_byte(int r, int c) { const int st = (r >> 4) * 2 + (c >> 5), rr = r & 15, cc = c & 31, ob = rr * 64 + cc * 2; return st * 1024 + (ob ^ (((ob >> 9) & 1) << 5)); }
__host__ __device__ __forceinline__ void stage_rc(int b, int& R, int& C) { const int st = b / 1024, sb = b % 1024, swz = sb ^ (((sb >> 9) & 1) << 5); R = (st >> 1) * 16 + swz / 64; C = (st & 1) * 32 + (swz % 64) / 2; }
__host__ __device__ __forceinline__ int perm32(int rho) { const int n = rho >> 4, i = rho & 15; return 8 * (i >> 2) + 4 * n + (i & 3); }

struct Unit { int pm, pn; };
struct Gemm { const bf16_t* A; const bf16_t* Bt; int M, N, K; int lda; int kstepA; };
struct StaticOrder {
    int nM, nN, nwg, G, c, rep, pm0;
    __device__ void init(int M_, int N_, int G_, int c_, int rep_ = 1, int pm0_ = 0) { nM = M_ / BM; nN = N_ / BM; nwg = nM * nN; G = G_; c = c_; rep = rep_; pm0 = pm0_; }
    __device__ bool next(int i, Unit& u) const {
        const long L = (long)i * G + c; if (L >= (long)nwg * rep) return false;
        int wgid = (int)(L % nwg); { const int q = nwg / NXCD, r = nwg % NXCD, xcd = wgid % NXCD, off = wgid / NXCD; wgid = (xcd < r ? xcd * (q + 1) : r * (q + 1) + (xcd - r) * q) + off; }
        const int nig = WGM * nN, gid = wgid / nig, fm = gid * WGM, gsz = (nM - fm) < WGM ? (nM - fm) : WGM;
        u.pm = pm0 + fm + ((wgid % nig) % gsz); u.pn = (wgid % nig) / gsz; return true;
    }
};

struct EpiIn {
    static constexpr bool HEADPERM = true, MID = false;
    bf16_t *Q, *Kp, *Vt, *U, *G; const float *gq, *gk;
    __device__ __forceinline__ void operator()(const f32x4 (&acc)[2][2][4][2], const Unit& u, int wr, int wc, int fr, int fq) const {
        const int sec = u.pn >> 1, half = u.pn & 1, b = u.pm >> 3, pml = u.pm & 7;
        if (sec <= 1) {
            const float* gp = sec == 0 ? gq : gk; const float sc = sec == 0 ? C2 : 1.0f;
            f32x4 gv[2][2];
#pragma unroll
            for (int bj = 0; bj < 2; ++bj)
#pragma unroll
                for (int n = 0; n < 2; ++n) gv[bj][n] = *(const f32x4*)(gp + 32 * bj + 8 * fq + 4 * n) * sc;
            bf16_t* base = (sec == 0 ? Q : Kp) + (size_t)(((b * 8 + half * 4 + wc) * 16 + fr) * 128) * 64;
#pragma unroll
            for (int ai = 0; ai < 2; ++ai)
#pragma unroll
                for (int m = 0; m < 4; ++m) {
                    float s = 0.f;
#pragma unroll
                    for (int bj = 0; bj < 2; ++bj)
#pragma unroll
                        for (int n = 0; n < 2; ++n) { const f32x4 x = acc[ai][bj][m][n]; s += (x[0] * x[0] + x[1] * x[1]) + (x[2] * x[2] + x[3] * x[3]); }
                    s = xor16_32_sum(s);
                    const float r = rsqrtf(s * (1.0f / 64.0f) + EPS);
                    const int i = 16 * pml + 8 * wr + 4 * ai + m;
#pragma unroll
                    for (int bj = 0; bj < 2; ++bj) {
                        const f32x4 v0 = acc[ai][bj][m][0] * r * gv[bj][0], v1 = acc[ai][bj][m][1] * r * gv[bj][1];
                        u32x4 w; w.x = pk2(v0[0], v0[1]); w.y = pk2(v0[2], v0[3]); w.z = pk2(v1[0], v1[1]); w.w = pk2(v1[2], v1[3]);
                        *(u32x4*)(base + (size_t)i * 64 + 32 * bj + 8 * fq) = w;
                    }
                }
        } else if (sec == 2) {
            bf16_t* base = Vt + (size_t)((((b * 8 + half * 4 + wc) * 16 + fr) * 16 + (2 * pml + wr)) * 64) * 8;
#pragma unroll
            for (int bj = 0; bj < 2; ++bj)
#pragma unroll
                for (int n = 0; n < 2; ++n)
#pragma unroll
                    for (int j = 0; j < 4; ++j) {
                        const int d = 32 * bj + 8 * fq + 4 * n + j;
                        u32x4 w;
                        w.x = pk2(acc[0][bj][0][n][j], acc[0][bj][1][n][j]); w.y = pk2(acc[0][bj][2][n][j], acc[0][bj][3][n][j]);
                        w.z = pk2(acc[1][bj][0][n][j], acc[1][bj][1][n][j]); w.w = pk2(acc[1][bj][2][n][j], acc[1][bj][3][n][j]);
                        *(u32x4*)(base + (size_t)d * 8) = w;
                    }
        } else {
            bf16_t* base = (sec == 3 ? U : G);
            const int col0 = 256 * half + 64 * wc + 8 * fq;
#pragma unroll
            for (int ai = 0; ai < 2; ++ai)
#pragma unroll
                for (int m = 0; m < 4; ++m) {
                    const size_t row = (size_t)u.pm * 256 + 128 * wr + 64 * ai + 16 * m + fr;
#pragma unroll
                    for (int bj = 0; bj < 2; ++bj) {
                        const f32x4 a0 = acc[ai][bj][m][0], a1 = acc[ai][bj][m][1];
                        u32x4 w; w.x = pk2(gelu_t(a0[0]), gelu_t(a0[1])); w.y = pk2(gelu_t(a0[2]), gelu_t(a0[3]));
                        w.z = pk2(gelu_t(a1[0]), gelu_t(a1[1])); w.w = pk2(gelu_t(a1[2]), gelu_t(a1[3]));
                        *(u32x4*)(base + row * 512 + col0 + 32 * bj) = w;
                    }
                }
        }
    }
};
struct EpiOut {
    static constexpr bool HEADPERM = false, MID = true;
    const float* x; bf16_t* XB; float* ssq; const float* ssqA;
    __device__ __forceinline__ void mid(f32x4 (&acc)[2][2][4][2], const Unit& u, int wr, int wc, int fr, int fq) const {
#pragma unroll
        for (int ai = 0; ai < 2; ++ai)
#pragma unroll
            for (int m = 0; m < 4; ++m) {
                const size_t row = (size_t)u.pm * 256 + 128 * wr + 64 * ai + 16 * m + fr;
                const f32x4* sp = (const f32x4*)(ssqA + row * 8);
                const f32x4 t = sp[0] + sp[1];
                const float r = rsqrtf(((t[0] + t[1]) + (t[2] + t[3])) * (1.0f / AW) + EPS);
#pragma unroll
                for (int bj = 0; bj < 2; ++bj)
#pragma unroll
                    for (int n = 0; n < 2; ++n) acc[ai][bj][m][n] = acc[ai][bj][m][n] * r;
            }
    }
    __device__ __forceinline__ void operator()(const f32x4 (&acc)[2][2][4][2], const Unit& u, int wr, int wc, int fr, int fq) const {
#pragma unroll
        for (int ai = 0; ai < 2; ++ai)
#pragma unroll
            for (int m = 0; m < 4; ++m) {
                const size_t row = (size_t)u.pm * 256 + 128 * wr + 64 * ai + 16 * m + fr;
                const size_t off = row * DM + 256 * u.pn + 32 * wc + 8 * fq;
                float s = 0.f;
#pragma unroll
                for (int bj = 0; bj < 2; ++bj) {
                    const f32x4 v0 = *(const f32x4*)(x + off + 128 * bj) + acc[ai][bj][m][0], v1 = *(const f32x4*)(x + off + 128 * bj + 4) + acc[ai][bj][m][1];
                    s += (v0[0] * v0[0] + v0[1] * v0[1]) + (v0[2] * v0[2] + v0[3] * v0[3]) + (v1[0] * v1[0] + v1[1] * v1[1]) + (v1[2] * v1[2] + v1[3] * v1[3]);
                    u32x4 w; w.x = pk2(v0[0], v0[1]); w.y = pk2(v0[2], v0[3]); w.z = pk2(v1[0], v1[1]); w.w = pk2(v1[2], v1[3]);
                    *(u32x4*)(XB + off + 128 * bj) = w;
                }
                s = xor16_32_sum(s);
                if (fq == 0) ssq[row * 16 + u.pn * 4 + wc] = s;
            }
    }
};
struct EpiUp {
    static constexpr bool HEADPERM = false, MID = false;
    bf16_t* H; const float* ssq;
    __device__ __forceinline__ void operator()(const f32x4 (&acc)[2][2][4][2], const Unit& u, int wr, int wc, int fr, int fq) const {
#pragma unroll
        for (int ai = 0; ai < 2; ++ai)
#pragma unroll
            for (int m = 0; m < 4; ++m) {
                const size_t row = (size_t)u.pm * 256 + 128 * wr + 64 * ai + 16 * m + fr;
                const f32x4* sp = (const f32x4*)(ssq + row * 16);
                const f32x4 t = (sp[0] + sp[1]) + (sp[2] + sp[3]);
                const float r = rsqrtf(((t[0] + t[1]) + (t[2] + t[3])) * (1.0f / DM) + EPS);
                const size_t off = (((size_t)u.pm * 64 + 4 * u.pn + (wc >> 1)) * 256 + (128 * wr + 64 * ai + 16 * m + fr)) * 64 + 32 * (wc & 1) + 8 * fq;
#pragma unroll
                for (int bj = 0; bj < 2; ++bj) {
                    f32x4 v0 = acc[ai][bj][m][0] * r, v1 = acc[ai][bj][m][1] * r;
#pragma unroll
                    for (int j = 0; j < 4; ++j) { v0[j] = fmaxf(v0[j], 0.f); v1[j] = fmaxf(v1[j], 0.f); }
                    v0 = v0 * v0; v1 = v1 * v1;
                    u32x4 w; w.x = pk2(v0[0], v0[1]); w.y = pk2(v0[2], v0[3]); w.z = pk2(v1[0], v1[1]); w.w = pk2(v1[2], v1[3]);
                    *(u32x4*)(H + off + (size_t)bj * (2 * 256 * 64)) = w;
                }
            }
    }
};
struct EpiDown {
    static constexpr bool HEADPERM = false, MID = false;
    float* out; const bf16_t* XB;
    __device__ __forceinline__ void operator()(const f32x4 (&acc)[2][2][4][2], const Unit& u, int wr, int wc, int fr, int fq) const {
#pragma unroll
        for (int ai = 0; ai < 2; ++ai)
#pragma unroll
            for (int m = 0; m < 4; ++m) {
                const size_t row = (size_t)u.pm * 256 + 128 * wr + 64 * ai + 16 * m + fr;
                const size_t off = row * DM + 256 * u.pn + 32 * wc + 8 * fq;
#pragma unroll
                for (int bj = 0; bj < 2; ++bj) {
                    const u32x4 xr = *(const u32x4*)(XB + off + 128 * bj);
                    f32x4 v0, v1;
                    v0[0] = __builtin_bit_cast(float, xr[0] << 16); v0[1] = __builtin_bit_cast(float, xr[0] & 0xffff0000u); v0[2] = __builtin_bit_cast(float, xr[1] << 16); v0[3] = __builtin_bit_cast(float, xr[1] & 0xffff0000u);
                    v1[0] = __builtin_bit_cast(float, xr[2] << 16); v1[1] = __builtin_bit_cast(float, xr[2] & 0xffff0000u); v1[2] = __builtin_bit_cast(float, xr[3] << 16); v1[3] = __builtin_bit_cast(float, xr[3] & 0xffff0000u);
                    *(f32x4*)(out + off + 128 * bj) = v0 + acc[ai][bj][m][0]; *(f32x4*)(out + off + 128 * bj + 4) = v1 + acc[ai][bj][m][1];
                }
            }
    }
};

template <class Epi, class Sched>
__device__ __forceinline__ void gemm_phase(LAS unsigned char* lds, const Gemm g, const Sched& S, const Epi& E) {
    int tid_ = threadIdx.x; asm volatile("" : "+v"(tid_));
    const int tid = tid_, wid = __builtin_amdgcn_readfirstlane(tid >> 6), lane = tid & 63, wr = wid >> 2, wc = wid & 3, fr = lane & 15, fq = lane >> 4;
    const int K = g.K, nt = K / BK;
    unsigned voffA[2], voffB[2];
#pragma unroll
    for (int i = 0; i < 2; ++i) { int R, C; stage_rc(tid * 16 + i * 8192, R, C);
        const int Ra = 128 * (R >> 6) + (R & 63);
        const int Rb = Epi::HEADPERM ? (64 * (R >> 5) + perm32(R & 31)) : ((R & ~31) + perm32(R & 31));
        voffA[i] = (unsigned)(Ra * g.lda + C) * 2u; voffB[i] = (unsigned)(Rb * K + C) * 2u; }
    const size_t kstep = (size_t)(BK * 2);
    const size_t hstepA = (size_t)64 * g.lda * 2, kstepA = (size_t)g.kstepA;
    const size_t hstepB = (size_t)(Epi::HEADPERM ? 32 : 128) * K * 2;
    const size_t tstep = (size_t)256 * K * 2;
    const unsigned ldsw = (unsigned)wid * 1024u;
    const unsigned lds_u32 = (unsigned)(size_t)lds;
    const int aoff = lds_byte(wr * 64 + fr, fq * 8), boff = lds_byte(wc * 32 + fr, fq * 8);
#define PG8_SA(b, h) (((b) * 2 + (h)) * HTB)
#define PG8_SB(b, h) ((4 + (b) * 2 + (h)) * HTB)
#define PG8_STAGE(bufoff, gbase, voff) do { _Pragma("unroll") for (int _i = 0; _i < 2; ++_i) { unsigned _keep; \
        const unsigned _ld = (unsigned)__builtin_amdgcn_readfirstlane((int)(lds_u32 + (unsigned)(bufoff) + ldsw + (unsigned)(_i * 8192))); \
        asm volatile("s_mov_b32 %0, m0\n\ts_mov_b32 m0, %2\n\ts_nop 0\n\tglobal_load_lds_dwordx4 %1, %3\n\ts_mov_b32 m0, %0" \
                     : "=&s"(_keep) : "v"((voff)[_i]), "s"(_ld), "s"((const char*)(gbase)) : "memory"); } } while (0)
#define PG8_LDA(dst, b, h) do { _Pragma("unroll") for (int m = 0; m < 4; ++m) _Pragma("unroll") for (int k = 0; k < 2; ++k) dst[m][k] = *(const LAS bf16x8*)(lds + PG8_SA(b, h) + aoff + m * 2048 + k * 1024); } while (0)
#define PG8_LDB(dst, b, h) do { _Pragma("unroll") for (int n = 0; n < 2; ++n) _Pragma("unroll") for (int k = 0; k < 2; ++k) dst[n][k] = *(const LAS bf16x8*)(lds + PG8_SB(b, h) + boff + n * 2048 + k * 1024); } while (0)
#define PG8_MMA(ai, bj, At, Bt) do { __builtin_amdgcn_s_setprio(1); _Pragma("unroll") for (int m = 0; m < 4; ++m) _Pragma("unroll") for (int n = 0; n < 2; ++n) _Pragma("unroll") for (int k = 0; k < 2; ++k) \
        acc[ai][bj][m][n] = __builtin_amdgcn_mfma_f32_16x16x32_bf16(Bt[n][k], At[m][k], acc[ai][bj][m][n], 0, 0, 0); __builtin_amdgcn_s_setprio(0); } while (0)
#define PG8_WAIT_V(n) asm volatile("s_waitcnt vmcnt(" #n ")" ::: "memory")
#define PG8_WAIT_L(n) asm volatile("s_waitcnt lgkmcnt(" #n ")" ::: "memory")
#define PG8_BAR __builtin_amdgcn_s_barrier()
#define PG8_SCHED __builtin_amdgcn_sched_barrier(0)
    Unit cur, nxt; int ui = 0;
    if (!S.next(0, cur)) return;
    f32x4 acc[2][2][4][2];
#pragma unroll
    for (int a = 0; a < 2; ++a)
#pragma unroll
        for (int b = 0; b < 2; ++b)
#pragma unroll
            for (int m = 0; m < 4; ++m)
#pragma unroll
                for (int n = 0; n < 2; ++n) acc[a][b][m][n] = (f32x4){0.f, 0.f, 0.f, 0.f};
    bf16x8 At[4][2], B0[2][2], B1[2][2];
    const char* cA = (const char*)g.A + (size_t)cur.pm * tstep; const char* cB = (const char*)g.Bt + (size_t)cur.pn * tstep;
    PG8_STAGE(PG8_SB(0, 0), cB, voffB); PG8_STAGE(PG8_SB(0, 1), cB + hstepB, voffB); PG8_STAGE(PG8_SA(0, 0), cA, voffA); PG8_STAGE(PG8_SA(0, 1), cA + hstepA, voffA);
    if (wr == 1) PG8_BAR;
    PG8_WAIT_V(2); PG8_BAR;
    PG8_STAGE(PG8_SB(1, 0), cB + kstep, voffB); PG8_STAGE(PG8_SA(1, 0), cA + kstepA, voffA); PG8_STAGE(PG8_SB(1, 1), cB + hstepB + kstep, voffB);
    PG8_WAIT_V(6); PG8_BAR;
    for (;;) {
        const bool has_next = S.next(ui + 1, nxt);
        const char* nA = has_next ? (const char*)g.A + (size_t)nxt.pm * tstep : cA; const char* nB = has_next ? (const char*)g.Bt + (size_t)nxt.pn * tstep : cB;
        for (int t = 0; t < nt; t += 2) {
            const bool last = (t == nt - 2);
            if constexpr (Epi::MID) { if (t == nt / 2) E.mid(acc, cur, wr, wc, fr, fq); }
            const char* a1 = cA + (size_t)(t + 1) * kstepA;
            const char* a2 = last ? nA : cA + (size_t)(t + 2) * kstepA; const char* b2 = last ? nB : cB + (size_t)(t + 2) * kstep;
            const char* a3 = a2 + kstepA; const char* b3 = b2 + kstep;
            PG8_LDB(B0, 0, 0); PG8_LDB(B1, 0, 1); PG8_SCHED; PG8_LDA(At, 0, 0); PG8_STAGE(PG8_SA(1, 1), a1 + hstepA, voffA);
            PG8_WAIT_V(8); PG8_WAIT_L(0); PG8_BAR; PG8_MMA(0, 0, At, B0); PG8_MMA(0, 1, At, B1); PG8_BAR; PG8_SCHED;
            PG8_LDA(At, 0, 1); PG8_STAGE(PG8_SB(0, 0), b2, voffB); PG8_STAGE(PG8_SB(0, 1), b2 + hstepB, voffB); PG8_STAGE(PG8_SA(0, 0), a2, voffA);
            PG8_WAIT_V(8); PG8_WAIT_L(0); PG8_BAR; PG8_MMA(1, 0, At, B0); PG8_MMA(1, 1, At, B1); PG8_BAR; PG8_SCHED;
            PG8_LDB(B0, 1, 0); PG8_LDB(B1, 1, 1); PG8_SCHED; PG8_LDA(At, 1, 0); PG8_STAGE(PG8_SA(0, 1), a2 + hstepA, voffA);
            PG8_WAIT_V(8); PG8_WAIT_L(0); PG8_BAR; PG8_MMA(0, 0, At, B0); PG8_MMA(0, 1, At, B1); PG8_BAR; PG8_SCHED;
            PG8_LDA(At, 1, 1); PG8_STAGE(PG8_SB(1, 0), b3, voffB); PG8_STAGE(PG8_SB(1, 1), b3 + hstepB, voffB); PG8_STAGE(PG8_SA(1, 0), a3, voffA);
            PG8_WAIT_V(8); PG8_WAIT_L(0); PG8_BAR; PG8_MMA(1, 0, At, B0); PG8_MMA(1, 1, At, B1); PG8_BAR; PG8_SCHED;
        }
        if (wr == 0) PG8_BAR;
        E(acc, cur, wr, wc, fr, fq);
        if (!has_next) break;
#pragma unroll
        for (int a = 0; a < 2; ++a)
#pragma unroll
            for (int b = 0; b < 2; ++b)
#pragma unroll
                for (int m = 0; m < 4; ++m)
#pragma unroll
                    for (int n = 0; n < 2; ++n) acc[a][b][m][n] = (f32x4){0.f, 0.f, 0.f, 0.f};
        cur = nxt; cA = nA; cB = nB; ++ui;
        if (wr == 1) PG8_BAR;
    }
    PG8_WAIT_V(0);
    PG8_BAR;
#undef PG8_SA
#undef PG8_SB
#undef PG8_STAGE
#undef PG8_LDA
#undef PG8_LDB
#undef PG8_MMA
#undef PG8_WAIT_V
#undef PG8_WAIT_L
#undef PG8_BAR
#undef PG8_SCHED
}
}

constexpr size_t MiB = 1u << 20;
constexpr size_t WS_WIN = 1 * MiB, WS_WOUT = 6 * MiB, WS_W1 = 8 * MiB, WS_W2 = 16 * MiB;
constexpr size_t WS_WSB = 27 * MiB;
constexpr size_t WS_SSQA = 26 * MiB;
constexpr size_t WS_SSQ = 24 * MiB;
constexpr size_t WS_XB = 32 * MiB;
constexpr size_t WS_Q = 96 * MiB, WS_K = 128 * MiB, WS_V = 160 * MiB, WS_U = 192 * MiB, WS_G = 224 * MiB, WS_MIX = 256 * MiB;
constexpr size_t WS_H = 96 * MiB;
constexpr size_t WS_END = 352 * MiB;
constexpr int LDS_BYTES = 157696, LDS_MISC = LDS_BYTES - 64;
constexpr size_t WS_CTL = 0, CTL_ZERO_BYTES = 16384;
constexpr int LDS_TT_PITCH = 272;
constexpr int LDS_SSQG = 4 * 128 * LDS_TT_PITCH;
constexpr int LDS_GG = LDS_SSQG + 2048;
constexpr int LDS_ATAB = 147456;
static_assert(LDS_ATAB + 64 * 144 <= LDS_BYTES - 64, "LDS map");

struct Args { const float* in[15]; float* out; unsigned char* ws; };

__device__ __forceinline__ void p0_transpose_item(const float* W, int K, int N, bf16_t* WT, const float* kscale, int klim, LAS float* scr, int item, int lane) {
    const int nblk = N / 32, kb = item / nblk, nb = item % nblk, k0 = 64 * kb, n0 = 32 * nb;
    float wv[32];
#pragma unroll
    for (int i = 0; i < 32; ++i) wv[i] = W[(size_t)(k0 + 2 * i + (lane >> 5)) * N + n0 + (lane & 31)];
#pragma unroll
    for (int i = 0; i < 32; ++i) { const int kk = 2 * i + (lane >> 5); float w = wv[i]; if (kscale && k0 + kk < klim) w *= kscale[k0 + kk]; scr[kk * 33 + (lane & 31)] = w; }
    asm volatile("s_waitcnt lgkmcnt(0)" ::: "memory");
    const int c = lane & 7;
#pragma unroll
    for (int j = 0; j < 4; ++j) { const int n = (lane >> 3) + 8 * j; const LAS float* s = scr + (8 * c) * 33 + n;
        u32x4 o; o.x = pk2(s[0 * 33], s[1 * 33]); o.y = pk2(s[2 * 33], s[3 * 33]); o.z = pk2(s[4 * 33], s[5 * 33]); o.w = pk2(s[6 * 33], s[7 * 33]);
        *(u32x4*)(WT + (size_t)(n0 + n) * K + k0 + 8 * c) = o; }
    asm volatile("s_waitcnt lgkmcnt(0)" ::: "memory");
}
__device__ __forceinline__ void rms_rows4_to_bf16(const float* x, const float* gain, bf16_t* o, size_t m0, size_t stride, int lane) {
    f32x4 v[4][4];
#pragma unroll
    for (int r = 0; r < 4; ++r) { const f32x4* xr = (const f32x4*)(x + (m0 + r * stride) * DM) + lane;
#pragma unroll
        for (int j = 0; j < 4; ++j) v[r][j] = xr[64 * j]; }
    f32x4 gr[4];
#pragma unroll
    for (int j = 0; j < 4; ++j) gr[j] = ((const f32x4*)gain + lane)[64 * j];
#pragma unroll
    for (int r = 0; r < 4; ++r) {
        float s = 0.f;
#pragma unroll
        for (int j = 0; j < 4; ++j) s += (v[r][j][0] * v[r][j][0] + v[r][j][1] * v[r][j][1]) + (v[r][j][2] * v[r][j][2] + v[r][j][3] * v[r][j][3]);
        const float rstd = rsqrtf(wave_sum(s) * (1.f / DM) + EPS);
        u32x2* o8 = (u32x2*)(o + (m0 + r * stride) * DM) + lane;
#pragma unroll
        for (int j = 0; j < 4; ++j) { const f32x4 y = v[r][j] * rstd * gr[j]; u32x2 w; w.x = pk2(y[0], y[1]); w.y = pk2(y[2], y[3]); o8[64 * j] = w; }
    }
}

constexpr int KC_PITCH = 160, LDS_KC = 0, LDS_VC = 16 * 32 * KC_PITCH;
static_assert(LDS_VC + 65536 <= LDS_ATAB, "attention LDS: K image | V image | multiplicity tables (the gMLP scratch overlays the images: different units, barrier-separated)");
__device__ __forceinline__ void run_desc(int tt, int g, int c, int R0, int& cg, int& Rg) {
    if (tt < 4) { cg = c; Rg = R0 - 16 + 4 * tt + g; }
    else if (tt < 7) { cg = (c + 4 * (tt - 3)) & 15; Rg = R0 - 4 + g; }
    else if (tt < 10) { const int o = 4 * (tt - 7) + g; const int o3 = (o * 11) >> 5; cg = (c + 1 + o3 * 4 + (o - 3 * o3)) & 15; Rg = R0 - 1; }
    else { cg = tt - 10; Rg = R0 + g; }
}
__device__ __forceinline__ bool tile_valid(int tt, int R0) {
    if (tt < 4) return R0 - 16 + 4 * tt >= 0;
    if (tt < 7) return R0 >= 4;
    if (tt < 10) return R0 >= 1;
    return true;
}
__device__ __forceinline__ int next_tile(int tt, int R0) { while (tt < 26 && !tile_valid(tt, R0)) ++tt; return tt; }

struct AttnP { const bf16_t *Q, *K, *Vt; bf16_t* MIX; float* ssqA; const float *gq, *gk; };

__device__ __forceinline__ void attn_load_k(const AttnP& P, LAS unsigned char* lds, int hb, int tt, int c, int R0, int lane, bf16x8 (&kf)[4]) {
    const int rho = lane & 31, h = lane >> 5;
    const int gk_ = 2 * (rho >> 4) + ((rho >> 2) & 1), pk_ = 4 * ((rho >> 3) & 1) + (rho & 3);
    if (tt < 10) {
        int cg, Rg; run_desc(tt, gk_, c, R0, cg, Rg);
        const bf16_t* kp = P.K + ((size_t)(hb * 16 + cg) * 128 + 8 * Rg + pk_) * 64 + 8 * h;
#pragma unroll
        for (int kk = 0; kk < 4; ++kk) kf[kk] = *(const bf16x8*)(kp + 16 * kk);
    } else {
        const LAS unsigned char* kp = lds + LDS_KC + ((tt - 10) * 32 + 8 * gk_ + pk_) * KC_PITCH + 16 * h;
#pragma unroll
        for (int kk = 0; kk < 4; ++kk) kf[kk] = *(const LAS bf16x8*)(kp + 32 * kk);
    }
}
__device__ __forceinline__ void attn_load_v(const AttnP& P, LAS unsigned char* lds, int hb, int tt, int c, int R0, int lane, bf16x8 (&vf)[2][2]) {
    const int rho = lane & 31, h = lane >> 5;
    if (tt < 10) {
#pragma unroll
        for (int s = 0; s < 2; ++s) { int cg, Rg; run_desc(tt, 2 * s + h, c, R0, cg, Rg);
            const bf16_t* vp = P.Vt + ((size_t)((hb * 16 + cg) * 16 + Rg) * 64 + rho) * 8;
            vf[0][s] = *(const bf16x8*)(vp); vf[1][s] = *(const bf16x8*)(vp + 32 * 8); }
    } else {
#pragma unroll
        for (int s = 0; s < 2; ++s) { const LAS unsigned char* vp = lds + LDS_VC + (((tt - 10) * 4 + 2 * s + h) * 64 + rho) * 16;
            vf[0][s] = *(const LAS bf16x8*)(vp); vf[1][s] = *(const LAS bf16x8*)(vp + 512); }
    }
}

__device__ __forceinline__ unsigned long long mult_bytes(int D0, int T2, int T3) {
    const unsigned long long ONES = 0x0101010101010101ull;
    const int l1 = max((D0 - 128 + 15) >> 4, 0), l2 = max((D0 - T2 + 15) >> 4, 0), l3 = max((D0 - T3 + 15) >> 4, 0);
    const unsigned long long w = (l1 >= 8 ? 0ull : (ONES << (8 * l1))) + (l2 >= 8 ? 0ull : (ONES << (8 * l2))) + (l3 >= 8 ? 0ull : (ONES << (8 * l3)));
    const int hi = D0 >> 4;
    const unsigned long long mh = hi < 0 ? 0ull : (hi >= 7 ? ~0ull : ((1ull << (8 * (hi + 1))) - 1ull));
    return w & mh;
}

__device__ __forceinline__ void attn_tables(int lane, unsigned long long (&T)[18]) {
    const int q = lane & 31, h = lane >> 5;
#pragma unroll
    for (int eg = 0; eg < 2; ++eg) { const int u16 = 16 * (q - 8 * (2 * eg + h)), g = 2 * eg + h;
        T[0 + eg] = mult_bytes(u16 + 1, 4096, -1) - mult_bytes(u16 + 1, -1, -1);
        T[2 + eg] = mult_bytes(u16 - 1, 4096, -1) - mult_bytes(u16 - 1, -1, -1);
        T[4 + eg] = mult_bytes(u16 + 1, -1, -1); T[6 + eg] = mult_bytes(u16 - 1, -1, -1);
        T[8 + eg] = mult_bytes(16 * (q + 128 - 8 * g), 512, 2048); T[10 + eg] = mult_bytes(16 * (q + 32 - 8 * g), 512, 2048);
        T[12 + eg] = mult_bytes(4 + 16 * (q + 32 - 8 * g), 512, -1); T[14 + eg] = mult_bytes(-4 + 16 * (q + 32 - 8 * g), 512, -1); }
    T[16] = mult_bytes(1 + 16 * (q + 8), -1, -1); T[17] = mult_bytes(-1 + 16 * (q + 8), -1, -1);
}

__device__ __forceinline__ void tile_compute(const bf16x8 (&kf)[4], const bf16x8 (&vf)[2][2], const bf16x8 (&qf)[4], unsigned long long w0, unsigned long long w1,
                                             float shift, f32x16& o0, f32x16& o1, f32x16& zacc) {
    f32x16 st = {};
#pragma unroll
    for (int kk = 0; kk < 4; ++kk) st = __builtin_amdgcn_mfma_f32_32x32x16_bf16(kf[kk], qf[kk], st, 0, 0, 0);
    if (__builtin_amdgcn_readfirstlane(__builtin_bit_cast(int, shift)) != 0) {
        asm volatile("" ::: "memory");
#pragma unroll
        for (int e = 0; e < 16; ++e) st[e] -= shift;
    }
    unsigned pw[8];
#pragma unroll
    for (int eg = 0; eg < 2; ++eg) {
        const unsigned long long w = eg ? w1 : w0;
        const unsigned wl = (unsigned)w, wh = (unsigned)(w >> 32);
        float pv[8];
#pragma unroll
        for (int p = 0; p < 4; ++p) {
            pv[p] = (float)((wl >> (8 * p)) & 0xffu) * __builtin_amdgcn_exp2f(st[8 * eg + p]);
            pv[4 + p] = (float)((wh >> (8 * p)) & 0xffu) * __builtin_amdgcn_exp2f(st[8 * eg + 4 + p]);
        }
#pragma unroll
        for (int p = 0; p < 4; ++p) pw[4 * eg + p] = pk2(pv[2 * p], pv[2 * p + 1]);
    }
    const bf16x8 ones = {0x3F80, 0x3F80, 0x3F80, 0x3F80, 0x3F80, 0x3F80, 0x3F80, 0x3F80};
    const bf16x8 pf0 = __builtin_bit_cast(bf16x8, (u32x4){pw[0], pw[1], pw[2], pw[3]});
    const bf16x8 pf1 = __builtin_bit_cast(bf16x8, (u32x4){pw[4], pw[5], pw[6], pw[7]});
    o0 = __builtin_amdgcn_mfma_f32_32x32x16_bf16(vf[0][0], pf0, o0, 0, 0, 0);
    o1 = __builtin_amdgcn_mfma_f32_32x32x16_bf16(vf[1][0], pf0, o1, 0, 0, 0);
    zacc = __builtin_amdgcn_mfma_f32_32x32x16_bf16(ones, pf0, zacc, 0, 0, 0);
    o0 = __builtin_amdgcn_mfma_f32_32x32x16_bf16(vf[0][1], pf1, o0, 0, 0, 0);
    o1 = __builtin_amdgcn_mfma_f32_32x32x16_bf16(vf[1][1], pf1, o1, 0, 0, 0);
    zacc = __builtin_amdgcn_mfma_f32_32x32x16_bf16(ones, pf1, zacc, 0, 0, 0);
}

__device__ __forceinline__ void attn_task(const AttnP& P, LAS unsigned char* lds, int b, int hd, int qq, int c, float shift, int lane_in) {
    int lane = lane_in; asm volatile("" : "+v"(lane));
    const int hb = b * 8 + hd, q = lane & 31, h = lane >> 5, R0 = 4 * qq, iq0 = 32 * qq;
    bf16x8 qf[4];
    { const bf16_t* qp = P.Q + ((size_t)(hb * 16 + c) * 128 + iq0 + q) * 64 + 8 * h;
#pragma unroll
      for (int kk = 0; kk < 4; ++kk) qf[kk] = *(const bf16x8*)(qp + 16 * kk); }
    bf16x8 gk[4];
    int gi = next_tile(0, R0);
    if (gi < 10) attn_load_k(P, lds, hb, gi, c, R0, lane, gk);
    unsigned long long Hp[2], Hn[2], Bp[2], Bn[2], mT0[2], mT3[2], mAp[2], mAn[2], mLp, mLn;
    { const LAS unsigned long long* T = (const LAS unsigned long long*)(lds + LDS_ATAB + lane * 144);
      Hp[0] = T[0]; Hp[1] = T[1]; Hn[0] = T[2]; Hn[1] = T[3]; Bp[0] = T[4]; Bp[1] = T[5]; Bn[0] = T[6]; Bn[1] = T[7];
      mT0[0] = T[8]; mT0[1] = T[9]; mT3[0] = T[10]; mT3[1] = T[11]; mAp[0] = T[12]; mAp[1] = T[13]; mAn[0] = T[14]; mAn[1] = T[15]; mLp = T[16]; mLn = T[17]; }
    f32x16 o0 = {}, o1 = {}, zacc = {};
    int li = 10, ph = 0;
#pragma clang loop unroll(disable)
    while (li < 26 || gi < 10) {
        bf16x8 kf[4], vf[2][2];
        unsigned long long w0, w1;
        if (gi < 10 && (ph >= 2 || li >= 26)) {
            attn_load_v(P, lds, hb, gi, c, R0, lane, vf);
#pragma unroll
            for (int kk = 0; kk < 4; ++kk) kf[kk] = gk[kk];
            if (gi < 4) {
                if (gi == 0) { w0 = mT0[0]; w1 = mT0[1]; } else if (gi == 3) { w0 = mT3[0]; w1 = mT3[1]; } else { w0 = 0x0101010101010101ull; w1 = 0x0101010101010101ull; }
            } else if (gi < 7) {
                const bool pos = c > ((c + 4 * (gi - 3)) & 15);
                w0 = pos ? mAp[0] : mAn[0]; w1 = pos ? mAp[1] : mAn[1];
            } else {
                { int cg, Rg; run_desc(gi, h, c, R0, cg, Rg); w0 = (c > cg) ? mLp : mLn; }
                { int cg, Rg; run_desc(gi, 2 + h, c, R0, cg, Rg); w1 = (c > cg) ? mLp : mLn; }
            }
            gi = next_tile(gi + 1, R0);
            if (gi < 10) attn_load_k(P, lds, hb, gi, c, R0, lane, gk);
            ph = 0;
        } else {
            attn_load_k(P, lds, hb, li, c, R0, lane, kf); attn_load_v(P, lds, hb, li, c, R0, lane, vf);
            const int dl = c - (li - 10);
            if (dl == 0) { w0 = 3 * Hp[0] - Hn[0] + Bn[0]; w1 = 3 * Hp[1] - Hn[1] + Bn[1]; }
            else if (dl > 0) { const unsigned long long m = ((dl & 3) == 0) ? ~0ull : 0ull; w0 = Bp[0] + (Hp[0] & m); w1 = Bp[1] + (Hp[1] & m); }
            else { const unsigned long long m = ((dl & 3) == 0) ? ~0ull : 0ull; w0 = Bn[0] + (Hn[0] & m); w1 = Bn[1] + (Hn[1] & m); }
            ++li; ++ph;
        }
        tile_compute(kf, vf, qf, w0, w1, shift, o0, o1, zacc);
    }
    const float rz = 1.0f / zacc[0];
    float ss = 0.f;
#pragma unroll
    for (int e = 0; e < 16; ++e) { o0[e] *= rz; o1[e] *= rz; ss += o0[e] * o0[e] + o1[e] * o1[e]; }
    ss = xor32_sum(ss);
    const size_t tok = (size_t)b * SEQ + c + 16 * (iq0 + q);
    if (h == 0) P.ssqA[tok * 8 + hd] = ss;
    bf16_t* orow = P.MIX + tok * DM + hd * 64;
#pragma unroll
    for (int e4 = 0; e4 < 4; ++e4) {
        const int d0 = 8 * e4 + 4 * h;
        u32x2 w0, w1;
        w0.x = pk2(o0[4 * e4], o0[4 * e4 + 1]); w0.y = pk2(o0[4 * e4 + 2], o0[4 * e4 + 3]);
        w1.x = pk2(o1[4 * e4], o1[4 * e4 + 1]); w1.y = pk2(o1[4 * e4 + 2], o1[4 * e4 + 3]);
        *(u32x2*)(orow + d0) = w0; *(u32x2*)(orow + 32 + d0) = w1;
    }
}

__device__ __forceinline__ void attn_unit(const AttnP& P, LAS unsigned char* lds, int b, int hd, int qq, int wave, int lane) {
    int tid_ = threadIdx.x; asm volatile("" : "+v"(tid_));
    const int hb = b * 8 + hd, tid = tid_;
    float shift;
    { const float mq = wave_max(fabsf(P.gq[lane])), mk = wave_max(fabsf(P.gk[lane])); shift = fminf(8.0f * mq * mk * 1.4426950408889634f, 64.0f); shift = shift > 30.0f ? shift : 0.f; }
    {
        u32x4 kr[8], vr[8];
#pragma unroll
        for (int j = 0; j < 8; ++j) { const int chunk = tid + 512 * j, row = chunk >> 3, piece = chunk & 7, cls = row >> 5, il = row & 31;
            kr[j] = *(const u32x4*)(P.K + ((size_t)(hb * 16 + cls) * 128 + 32 * qq + il) * 64 + piece * 8); }
#pragma unroll
        for (int j = 0; j < 8; ++j) { const int chunk = tid + 512 * j, cls = chunk >> 8, within = chunk & 255;
            vr[j] = *(const u32x4*)(P.Vt + ((size_t)(hb * 16 + cls) * 16 + 4 * qq) * 512 + within * 8); }
        __syncthreads();
#pragma unroll
        for (int j = 0; j < 8; ++j) { const int chunk = tid + 512 * j, row = chunk >> 3, piece = chunk & 7;
            *(LAS u32x4*)(lds + LDS_KC + row * KC_PITCH + piece * 16) = kr[j]; }
#pragma unroll
        for (int j = 0; j < 8; ++j) { const int chunk = tid + 512 * j; *(LAS u32x4*)(lds + LDS_VC + chunk * 16) = vr[j]; }
    }
    __syncthreads();
    attn_task(P, lds, b, hd, qq, wave, shift, lane);
    attn_task(P, lds, b, hd, qq, wave + 8, shift, lane);
}

struct GmlpP { const bf16_t *U, *G; bf16_t* MIX; const float *lng, *lnb; const bf16_t* wsb; const float *bs, *go; };
__device__ __forceinline__ void gmlp_unit(const GmlpP& P, int b, int ch, LAS unsigned char* lds, int wave, int lane_in) {
    int lane = lane_in; asm volatile("" : "+v"(lane));
    const size_t tok0 = (size_t)b * SEQ + (size_t)ch * 128;
    const int gI = wave >> 1, th = wave & 1;
    {
        const int sub = lane & 15, rr = lane >> 4;
        const f32x4 ga0 = *(const f32x4*)(P.lng + gI * 128 + 8 * sub), ga1 = *(const f32x4*)(P.lng + gI * 128 + 8 * sub + 4);
        const f32x4 be0 = *(const f32x4*)(P.lnb + gI * 128 + 8 * sub), be1 = *(const f32x4*)(P.lnb + gI * 128 + 8 * sub + 4);
        u32x4 rawv[16];
#pragma unroll
        for (int it = 0; it < 16; ++it) rawv[it] = *(const u32x4*)(P.G + (tok0 + 64 * th + 16 * rr + it) * GW + gI * 128 + 8 * sub);
        const f32x4 gstage = (threadIdx.x < 128) ? *(const f32x4*)(P.go + (threadIdx.x & 127) * 4) : (f32x4){0.f, 0.f, 0.f, 0.f};
        __syncthreads();
        if (threadIdx.x < 128) *(LAS f32x4*)(lds + LDS_GG + threadIdx.x * 16) = gstage;
#pragma unroll
        for (int hf = 0; hf < 2; ++hf) {
            float yv[8][8];
#pragma unroll
            for (int i = 0; i < 8; ++i) {
                const u32x4 raw = rawv[8 * hf + i];
                float v[8];
#pragma unroll
                for (int j = 0; j < 4; ++j) { v[2 * j] = __builtin_bit_cast(float, raw[j] << 16); v[2 * j + 1] = __builtin_bit_cast(float, raw[j] & 0xffff0000u); }
                float sm = 0.f;
#pragma unroll
                for (int j = 0; j < 8; ++j) sm += v[j];
                sm = row16_sum(sm);
                const float mu = sm * (1.0f / 128.0f);
                float sq = 0.f;
#pragma unroll
                for (int j = 0; j < 8; ++j) { v[j] -= mu; sq += v[j] * v[j]; }
                sq = row16_sum(sq);
                const float rs = rsqrtf(sq * (1.0f / 128.0f) + EPS);
#pragma unroll
                for (int j = 0; j < 8; ++j) yv[j][i] = v[j] * rs * (j < 4 ? ga0[j & 3] : ga1[j & 3]) + (j < 4 ? be0[j & 3] : be1[j & 3]);
            }
            const int s0 = 64 * th + 16 * rr + 8 * hf;
            LAS unsigned char* dst = lds + (gI * 128 + 8 * sub) * LDS_TT_PITCH + 16 * ((s0 >> 3) ^ sub);
#pragma unroll
            for (int j = 0; j < 8; ++j) {
                u32x4 w; w.x = pk2(yv[j][0], yv[j][1]); w.y = pk2(yv[j][2], yv[j][3]); w.z = pk2(yv[j][4], yv[j][5]); w.w = pk2(yv[j][6], yv[j][7]);
                *(LAS u32x4*)(dst + j * LDS_TT_PITCH) = w;
            }
            asm volatile("" ::: "memory");
        }
    }
    const int r32 = lane & 31, h = lane >> 5;
    const int tt0 = th, tt1 = 3 - th;
    bf16x8 bw0[4], bw1[8];
    { const bf16_t* w0p = P.wsb + ((size_t)(gI * 128 + 32 * tt0 + r32) * 128 + 8 * h);
      const bf16_t* w1p = P.wsb + ((size_t)(gI * 128 + 32 * tt1 + r32) * 128 + 8 * h);
#pragma unroll
      for (int ks = 0; ks < 4; ++ks) bw0[ks] = *(const bf16x8*)(w0p + 16 * ks);
#pragma unroll
      for (int ks = 0; ks < 8; ++ks) bw1[ks] = *(const bf16x8*)(w1p + 16 * ks); }
    __syncthreads();
    f32x16 acc[4][2];
#pragma unroll
    for (int mt = 0; mt < 4; ++mt) { acc[mt][0] = (f32x16){}; acc[mt][1] = (f32x16){}; }
    {
#pragma unroll
        for (int ks = 0; ks < 8; ++ks)
#pragma unroll
            for (int mt = 0; mt < 4; ++mt) {
                const int cc = 32 * mt + r32;
                const bf16x8 a = *(const LAS bf16x8*)(lds + (gI * 128 + cc) * LDS_TT_PITCH + 16 * ((2 * ks + h) ^ ((cc >> 3) & 15)));
                if (ks < 4) acc[mt][0] = __builtin_amdgcn_mfma_f32_32x32x16_bf16(a, bw0[ks], acc[mt][0], 0, 0, 0);
                acc[mt][1] = __builtin_amdgcn_mfma_f32_32x32x16_bf16(a, bw1[ks], acc[mt][1], 0, 0, 0);
                if (mt == 3 && (ks & 1)) asm volatile("" ::: "memory");
            }
    }
    LAS float* ssqg = (LAS float*)(lds + LDS_SSQG);
#pragma unroll
    for (int nt = 0; nt < 2; ++nt) {
        const int t = 32 * (nt == 0 ? tt0 : tt1) + r32;
        const float bsv = P.bs[gI * 128 + t];
        const bf16_t* up = P.U + (tok0 + t) * GW + gI * 128 + 4 * h;
        float ss = 0.f;
        u32x2 uraw[4][4];
#pragma unroll
        for (int mt = 0; mt < 4; ++mt)
#pragma unroll
            for (int e4 = 0; e4 < 4; ++e4) uraw[mt][e4] = *(const u32x2*)(up + 32 * mt + 8 * e4);
#pragma unroll
        for (int mt = 0; mt < 4; ++mt)
#pragma unroll
            for (int e4 = 0; e4 < 4; ++e4) {
                const u32x2 raw = uraw[mt][e4];
                const float u0 = __builtin_bit_cast(float, raw.x << 16), u1 = __builtin_bit_cast(float, raw.x & 0xffff0000u);
                const float u2 = __builtin_bit_cast(float, raw.y << 16), u3 = __builtin_bit_cast(float, raw.y & 0xffff0000u);
                float m0 = u0 * (acc[mt][nt][4 * e4] + bsv), m1 = u1 * (acc[mt][nt][4 * e4 + 1] + bsv), m2 = u2 * (acc[mt][nt][4 * e4 + 2] + bsv), m3 = u3 * (acc[mt][nt][4 * e4 + 3] + bsv);
                acc[mt][nt][4 * e4] = m0; acc[mt][nt][4 * e4 + 1] = m1; acc[mt][nt][4 * e4 + 2] = m2; acc[mt][nt][4 * e4 + 3] = m3;
                ss += (m0 * m0 + m1 * m1) + (m2 * m2 + m3 * m3);
            }
        ss = xor32_sum(ss);
        if (h == 0) ssqg[gI * 128 + t] = ss;
    }
    __syncthreads();
#pragma unroll
    for (int nt = 0; nt < 2; ++nt) {
        const int t = 32 * (nt == 0 ? tt0 : tt1) + r32;
        const float tot = (ssqg[t] + ssqg[128 + t]) + (ssqg[256 + t] + ssqg[384 + t]);
        const float r = rsqrtf(tot * (1.0f / GW) + EPS);
        bf16_t* op = P.MIX + (tok0 + t) * DM + AW + gI * 128 + 4 * h;
#pragma unroll
        for (int mt = 0; mt < 4; ++mt)
#pragma unroll
            for (int e4 = 0; e4 < 4; ++e4) {
                const f32x4 gg = *(const LAS f32x4*)(lds + LDS_GG + (gI * 128 + 32 * mt + 8 * e4 + 4 * h) * 4);
                u32x2 w; w.x = pk2(acc[mt][nt][4 * e4] * r * gg[0], acc[mt][nt][4 * e4 + 1] * r * gg[1]); w.y = pk2(acc[mt][nt][4 * e4 + 2] * r * gg[2], acc[mt][nt][4 * e4 + 3] * r * gg[3]);
                *(u32x2*)(op + 32 * mt + 8 * e4) = w;
            }
    }
}

typedef __attribute__((address_space(1))) unsigned gu32;
#define XB_TMO      128
#define XB_XCNT(j)  (256  + 64 * (j))
#define XB_XSUB(j)  (1280 + 64 * (j))
#define XB_XGEN(j)  (2304 + 64 * (j))
#define XB_TOP      3328
#define XB_TOPGEN   3392
#define XCD_BAR_WORDS 3456
#define XB_SPIN_CAP (1u << 18)
__device__ __forceinline__ unsigned xb_ld(unsigned* p)              { return __hip_atomic_load(p, __ATOMIC_RELAXED, __HIP_MEMORY_SCOPE_AGENT); }
__device__ __forceinline__ unsigned xb_add(unsigned* p, unsigned v) { return __hip_atomic_fetch_add(p, v, __ATOMIC_RELAXED, __HIP_MEMORY_SCOPE_AGENT); }
__device__ __forceinline__ unsigned xb_xcc_id() { return (unsigned)__builtin_amdgcn_s_getreg((3 << 11) | 20) & 0xFu; }
#define XB_SPIN(cond, bar) do { unsigned _sp = 0; while (cond) { __builtin_amdgcn_s_sleep(1); \
    if ((++_sp & 255u) == 0u) { if (xb_ld(&(bar)[XB_TMO])) break; if (_sp > XB_SPIN_CAP) { atomicAdd(&(bar)[XB_TMO], 1u); break; } } } } while (0)
struct XcdBarrier { unsigned* bar; unsigned x; volatile LAS unsigned* st; };
__device__ __forceinline__ XcdBarrier xcd_barrier_post(unsigned* bar, volatile LAS unsigned* st) {
    XcdBarrier b; b.bar = bar; b.x = xb_xcc_id(); b.st = st;
    if (threadIdx.x == 0) (void)xb_add(&bar[XB_XCNT(b.x)], 1u);
    return b;
}
__device__ __forceinline__ void xcd_barrier_complete(unsigned* bar, unsigned x, unsigned& nloc, unsigned& nx) {
    const unsigned G = gridDim.x * gridDim.y * gridDim.z;
    unsigned sum, cnt, mine, sp = 0u;
    for (;;) {
        sum = 0u; cnt = 0u; mine = 0u;
#pragma unroll
        for (unsigned j = 0; j < 16; ++j) { const unsigned c = xb_ld(&bar[XB_XCNT(j)]); sum += c; cnt += (c > 0u) ? 1u : 0u; mine = (j == x) ? c : mine; }
        if (sum == G) break;
        __builtin_amdgcn_s_sleep(1);
        if ((++sp & 255u) == 0u) { if (xb_ld(&bar[XB_TMO])) break; if (sp > XB_SPIN_CAP) { atomicAdd(&bar[XB_TMO], 1u); break; } }
    }
    nloc = mine > 0u ? mine : 1u; nx = cnt > 0u ? cnt : 1u;
}
__device__ __forceinline__ void xcd_barrier(const XcdBarrier& b) {
    asm volatile("s_waitcnt vmcnt(0)" ::: "memory");
    __syncthreads();
    if (threadIdx.x == 0) {
        unsigned* bar = b.bar;
        __builtin_amdgcn_s_waitcnt(0);
        unsigned nloc = b.st[0], nx = b.st[1];
        if (nloc == 0u) { xcd_barrier_complete(bar, b.x, nloc, nx); b.st[0] = nloc; b.st[1] = nx; }
        const unsigned old = xb_add(&bar[XB_XSUB(b.x)], 1u);
        const unsigned gen = old / nloc;
        if (old + 1u == (gen + 1u) * nloc) {
            __builtin_amdgcn_fence(__ATOMIC_RELEASE, "agent");
            asm volatile("s_waitcnt vmcnt(0)" ::: "memory");
            const unsigned og = xb_add(&bar[XB_TOP], 1u);
            const unsigned tg = og / nx;
            if (og + 1u == (tg + 1u) * nx) xb_add(&bar[XB_TOPGEN], 1u);
            else XB_SPIN(xb_ld(&bar[XB_TOPGEN]) == tg, bar);
            __builtin_amdgcn_fence(__ATOMIC_ACQUIRE, "agent");
            xb_add(&bar[XB_XGEN(b.x)], 1u);
            asm volatile("s_waitcnt vmcnt(0)" ::: "memory");
        } else {
            XB_SPIN(xb_ld(&bar[XB_XGEN(b.x)]) == gen, bar);
            __builtin_amdgcn_fence(__ATOMIC_ACQUIRE, "agent");
            asm volatile("s_waitcnt vmcnt(0)" ::: "memory");
        }
    }
    __syncthreads();
}

#ifndef REP_P0
#define REP_P0 1
#endif
#ifndef REP_P1
#define REP_P1 1
#endif
#ifndef REP_P2
#define REP_P2 1
#endif
#ifndef REP_GM
#define REP_GM 1
#endif
#ifndef REP_P3
#define REP_P3 1
#endif
#ifndef REP_P4
#define REP_P4 1
#endif
__global__ void __launch_bounds__(512, 2) mk_fwd(Args args) {
    extern __shared__ __attribute__((aligned(16))) unsigned char lds_raw[];
    LAS unsigned char* lds = (LAS unsigned char*)lds_raw;
    const int tid = threadIdx.x, lane = tid & 63, wave = __builtin_amdgcn_readfirstlane(tid >> 6);
    const int G = gridDim.x, bx = blockIdx.x;
    unsigned char* ws = args.ws;
    const float* x = args.in[0]; const float* norm1_g = args.in[1]; const float* w_in = args.in[2]; const float* q_norm_g = args.in[3]; const float* k_norm_g = args.in[4];
    const float* ln_v_g = args.in[5]; const float* ln_v_b = args.in[6]; const float* w_sp = args.in[7]; const float* b_sp = args.in[8];
    const float* attn_out_g = args.in[9]; const float* gmlp_out_g = args.in[10]; const float* w_out = args.in[11]; const float* norm2_g = args.in[12];
    const float* w_ff1 = args.in[13]; const float* w_ff2 = args.in[14];
    float* out = args.out;
    bf16_t* Win_t = (bf16_t*)(ws + WS_WIN); bf16_t* Wout_t = (bf16_t*)(ws + WS_WOUT); bf16_t* W1_t = (bf16_t*)(ws + WS_W1); bf16_t* W2_t = (bf16_t*)(ws + WS_W2);
    float* ssq = (float*)(ws + WS_SSQ); float* ssqA = (float*)(ws + WS_SSQA); bf16_t* Wsb = (bf16_t*)(ws + WS_WSB);
    bf16_t* XB = (bf16_t*)(ws + WS_XB); bf16_t* Qb = (bf16_t*)(ws + WS_Q); bf16_t* Kb = (bf16_t*)(ws + WS_K); bf16_t* Vt = (bf16_t*)(ws + WS_V);
    bf16_t* Ub = (bf16_t*)(ws + WS_U); bf16_t* Gb = (bf16_t*)(ws + WS_G); bf16_t* MIX = (bf16_t*)(ws + WS_MIX); bf16_t* Hb = (bf16_t*)(ws + WS_H);

    volatile LAS unsigned* MISC = (volatile LAS unsigned*)(lds + LDS_MISC);
    if (tid < 16) MISC[tid] = 0u;
    __syncthreads();
    const XcdBarrier bar = xcd_barrier_post((unsigned*)(ws + WS_CTL), MISC);
#ifndef SKIP_P0
    {
        LAS float* scr = (LAS float*)(lds + wave * 16384);
        const int gw = bx * 8 + wave, NGW = G * 8;
        constexpr int I_IN = (DM / 64) * (NIN / 32), I_OUT = (DM / 64) * (DM / 32), I_1 = (DM / 64) * (FF / 32), I_2 = (FF / 64) * (DM / 32);
        constexpr int NITEMS = I_IN + I_OUT + I_1 + I_2;
        for (int it = gw; it < NITEMS; it += NGW) {
            int r = it;
            if (r < I_IN) { p0_transpose_item(w_in, DM, NIN, Win_t, nullptr, 0, scr, r, lane); continue; } r -= I_IN;
            if (r < I_OUT) { p0_transpose_item(w_out, DM, DM, Wout_t, attn_out_g, AW, scr, r, lane); continue; } r -= I_OUT;
            if (r < I_1) { p0_transpose_item(w_ff1, DM, FF, W1_t, norm2_g, DM, scr, r, lane); continue; } r -= I_1;
            p0_transpose_item(w_ff2, FF, DM, W2_t, nullptr, 0, scr, r, lane);
        }
        for (int e = (bx * 512 + tid) * 2; e < 4 * 128 * 128; e += G * 512 * 2) {
            const int tt_ = (e >> 7) & 127, ss_ = e & 127; const f32x2 wv = *(const f32x2*)(w_sp + e);
            *(unsigned*)(Wsb + e) = pk2(ss_ <= tt_ ? wv[0] : 0.f, ss_ + 1 <= tt_ ? wv[1] : 0.f); }
        int m = gw;
        for (; m + 3 * NGW < M; m += 4 * NGW) rms_rows4_to_bf16(x, norm1_g, XB, (size_t)m, (size_t)NGW, lane);
        for (; m < M; m += NGW) rms_rows4_to_bf16(x, norm1_g, XB, (size_t)m, 0, lane);
    }
#endif
    xcd_barrier(bar);
#ifndef SKIP_P1
    {
        pg8::Gemm g{XB, Win_t, M, NIN, DM, DM, 128}; pg8::StaticOrder S; S.init(M, NIN, G, bx, REP_P1);
        pg8::EpiIn E{Qb, Kb, Vt, Ub, Gb, q_norm_g, k_norm_g};
        pg8::gemm_phase<pg8::EpiIn, pg8::StaticOrder>(lds, g, S, E);
    }
#endif
    xcd_barrier(bar);
#ifndef SKIP_P2
    {
#ifndef SKIP_ATT
        const AttnP AP{Qb, Kb, Vt, MIX, ssqA, q_norm_g, k_norm_g};
        if (wave == 0) { unsigned long long T[18]; attn_tables(lane, T); LAS unsigned long long* D = (LAS unsigned long long*)(lds + LDS_ATAB + lane * 144);
#pragma unroll
            for (int k = 0; k < 18; ++k) D[k] = T[k]; }
        __syncthreads();
        for (int p = bx; p < 256 * REP_P2; p += G) { const int pp = p & 255, hd = pp & 7, qa = (pp >> 3) & 1, b = pp >> 4;
            attn_unit(AP, lds, b, hd, 3 - qa, wave, lane); attn_unit(AP, lds, b, hd, qa, wave, lane); }
#endif
#ifndef SKIP_GMLP
        const GmlpP GP{Ub, Gb, MIX, ln_v_g, ln_v_b, Wsb, b_sp, gmlp_out_g};
        for (int a = bx; a < 256 * REP_GM; a += G) gmlp_unit(GP, (a & 255) >> 4, a & 15, lds, wave, lane);
#endif
    }
#endif
    xcd_barrier(bar);
#ifndef SKIP_P3
    {
        pg8::Gemm g{MIX, Wout_t, M, DM, DM, DM, 128}; pg8::StaticOrder S; S.init(M, DM, G, bx, REP_P3);
        pg8::EpiOut E{x, XB, ssq, ssqA};
        pg8::gemm_phase<pg8::EpiOut, pg8::StaticOrder>(lds, g, S, E);
    }
#endif
    xcd_barrier(bar);
#ifndef SKIP_P4
#pragma unroll 1
    for (int hf = 0; hf < 2; ++hf) {
        {
            pg8::Gemm g{XB, W1_t, M / 2, FF, DM, DM, 128}; pg8::StaticOrder S; S.init(M / 2, FF, G, bx, REP_P4, 64 * hf);
            pg8::EpiUp E{Hb, ssq};
            pg8::gemm_phase<pg8::EpiUp, pg8::StaticOrder>(lds, g, S, E);
        }
        xcd_barrier(bar);
        {
            pg8::Gemm g{Hb, W2_t, M / 2, DM, FF, 64, 256 * 64 * 2}; pg8::StaticOrder S; S.init(M / 2, DM, G, bx, 1, 64 * hf);
            pg8::EpiDown E{out, XB};
            pg8::gemm_phase<pg8::EpiDown, pg8::StaticOrder>(lds, g, S, E);
        }
    }
#endif
}

extern "C" void kernel_launch(void* const* d_in, const int* in_sizes, int n_in, void* d_out, int out_size, void* d_ws, size_t ws_size, hipStream_t stream) {
    static int grid = 0;
    if (grid == 0) {
        if (n_in != 15 || in_sizes[0] != M * DM || out_size != M * DM || ws_size < WS_END) { fprintf(stderr, "kernel_launch: unexpected shapes (n_in %d, in0 %d, out %d, ws %zu)\n", n_in, n_in > 0 ? in_sizes[0] : -1, out_size, ws_size); grid = -1; return; }
        int dev = 0, cus = 0, per_cu = 0;
        if (hipGetDevice(&dev) != hipSuccess || hipDeviceGetAttribute(&cus, hipDeviceAttributeMultiprocessorCount, dev) != hipSuccess) { grid = -1; return; }
        if (hipFuncSetAttribute((const void*)mk_fwd, hipFuncAttributeMaxDynamicSharedMemorySize, LDS_BYTES) != hipSuccess) { fprintf(stderr, "kernel_launch: hipFuncSetAttribute failed\n"); grid = -1; return; }
        if (hipOccupancyMaxActiveBlocksPerMultiprocessor(&per_cu, (const void*)mk_fwd, 512, LDS_BYTES) != hipSuccess || per_cu < 1) { fprintf(stderr, "kernel_launch: occupancy query says %d blocks per CU\n", per_cu); (void)hipGetLastError(); per_cu = 1; }
        grid = cus;
    }
    if (grid < 0) return;
    Args a{};
    for (int i = 0; i < 15; ++i) a.in[i] = (const float*)d_in[i];
    a.out = (float*)d_out; a.ws = (unsigned char*)d_ws;
    if (hipMemsetAsync((char*)d_ws + WS_CTL, 0, CTL_ZERO_BYTES, stream) != hipSuccess) { fprintf(stderr, "kernel_launch: memset failed\n"); return; }
    void* kargs[] = {&a};
    const hipError_t e = hipLaunchCooperativeKernel((const void*)mk_fwd, dim3(grid), dim3(512), kargs, LDS_BYTES, stream);
    if (e != hipSuccess) fprintf(stderr, "kernel_launch: cooperative launch failed: %s (grid %d)\n", hipGetErrorString(e), grid);
}
```

```cpp
#include <hip/hip_runtime.h>
#include <hip/hip_cooperative_groups.h>
#include <cstdio>
#include <cstdint>
namespace cg = cooperative_groups;

#define LAS __attribute__((address_space(3)))
typedef unsigned short bf16_t;
typedef short bf16x8 __attribute__((ext_vector_type(8)));
typedef float f32x4 __attribute__((ext_vector_type(4)));
typedef float f32x2 __attribute__((ext_vector_type(2)));
typedef float f32x16 __attribute__((ext_vector_type(16)));
typedef unsigned u32x4 __attribute__((ext_vector_type(4)));
typedef unsigned u32x2 __attribute__((ext_vector_type(2)));
typedef __bf16 bf16x2_t __attribute__((ext_vector_type(2)));

constexpr int BATCH = 16, SEQ = 2048, DM = 1024, M = BATCH * SEQ;
constexpr int NH = 8, HD = 64, AW = 512, GW = 512, NIN = 2560, FF = 4096;
constexpr float EPS = 1e-6f;
constexpr float C2 = 0.125f * 1.4426950408889634f;

__device__ __forceinline__ unsigned pk2(float lo, float hi) { f32x2 v = {lo, hi}; bf16x2_t b = __builtin_convertvector(v, bf16x2_t); return __builtin_bit_cast(unsigned, b); }
__device__ __forceinline__ float bf2f(unsigned short b) { return __builtin_bit_cast(float, (unsigned)b << 16); }
__device__ __forceinline__ float gelu_t(float x) {
    const float t = x * (1.0f + 0.044715f * x * x) * (-2.0f * 0.7978845608028654f * 1.4426950408889634f);
    return x * __builtin_amdgcn_rcpf(1.0f + __builtin_amdgcn_exp2f(t));
}
__device__ __forceinline__ float row16_sum(float v) {
    v += __builtin_bit_cast(float, __builtin_amdgcn_update_dpp(0, __builtin_bit_cast(int, v), 0x128, 0xf, 0xf, true));
    v += __builtin_bit_cast(float, __builtin_amdgcn_update_dpp(0, __builtin_bit_cast(int, v), 0x124, 0xf, 0xf, true));
    v += __builtin_bit_cast(float, __builtin_amdgcn_update_dpp(0, __builtin_bit_cast(int, v), 0x4E, 0xf, 0xf, true));
    v += __builtin_bit_cast(float, __builtin_amdgcn_update_dpp(0, __builtin_bit_cast(int, v), 0xB1, 0xf, 0xf, true));
    return v;
}
__device__ __forceinline__ float xor16_32_sum(float v) {
    { const auto r = __builtin_amdgcn_permlane16_swap(__float_as_uint(v), __float_as_uint(v), false, false); v = __uint_as_float(r[0]) + __uint_as_float(r[1]); }
    { const auto r = __builtin_amdgcn_permlane32_swap(__float_as_uint(v), __float_as_uint(v), false, false); v = __uint_as_float(r[0]) + __uint_as_float(r[1]); }
    return v;
}
__device__ __forceinline__ float xor32_sum(float v) {
    const auto r = __builtin_amdgcn_permlane32_swap(__float_as_uint(v), __float_as_uint(v), false, false); return __uint_as_float(r[0]) + __uint_as_float(r[1]);
}
__device__ __forceinline__ float wave_sum(float v) { return xor16_32_sum(row16_sum(v)); }
__device__ __forceinline__ float wave_max(float v) {
#pragma unroll
    for (int o = 1; o < 64; o <<= 1) v = fmaxf(v, __shfl_xor(v, o));
    return v;
}

namespace pg8 {
constexpr int BM = 256, BK = 64, HALF = 128, HTB = HALF * BK * 2, STAGE_BYTES = 8 * HTB, NXCD = 8, WGM = 8;
__host__ __device__ __forceinline__ int lds_byte(int r, int c) { const int st = (r >> 4) * 2 + (c >> 5), rr = r & 15, cc = c & 31, ob = rr * 64 + cc * 2; return st * 1024 + (ob ^ (((ob >> 9) & 1) << 5)); }
__host__ __device__ __forceinline__ void stage_rc(int b, int& R, int& C) { const int st = b / 1024, sb = b % 1024, swz = sb ^ (((sb >> 9) & 1) << 5); R = (st >> 1) * 16 + swz / 64; C = (st & 1) * 32 + (swz % 64) / 2; }
__host__ __device__ __forceinline__ int perm32(int rho) { const int n = rho >> 4, i = rho & 15; return 8 * (i >> 2) + 4 * n + (i & 3); }

struct Unit { int pm, pn; };
struct Gemm { const bf16_t* A; const bf16_t* Bt; int M, N, K; int lda; int kstepA; };
struct StaticOrder {
    int nM, nN, nwg, G, c, rep, pm0;
    __device__ void init(int M_, int N_, int G_, int c_, int rep_ = 1, int pm0_ = 0) { nM = M_ / BM; nN = N_ / BM; nwg = nM * nN; G = G_; c = c_; rep = rep_; pm0 = pm0_; }
    __device__ bool next(int i, Unit& u) const {
        const long L = (long)i * G + c; if (L >= (long)nwg * rep) return false;
        int wgid = (int)(L % nwg); { const int q = nwg / NXCD, r = nwg % NXCD, xcd = wgid % NXCD, off = wgid / NXCD; wgid = (xcd < r ? xcd * (q + 1) : r * (q + 1) + (xcd - r) * q) + off; }
        const int nig = WGM * nN, gid = wgid / nig, fm = gid * WGM, gsz = (nM - fm) < WGM ? (nM - fm) : WGM;
        u.pm = pm0 + fm + ((wgid % nig) % gsz); u.pn = (wgid % nig) / gsz; return true;
    }
};

struct EpiIn {
    static constexpr bool HEADPERM = true, MID = false;
    bf16_t *Q, *Kp, *Vt, *U, *G; const float *gq, *gk;
    __device__ __forceinline__ void operator()(const f32x4 (&acc)[2][2][4][2], const Unit& u, int wr, int wc, int fr, int fq) const {
        const int sec = u.pn >> 1, half = u.pn & 1, b = u.pm >> 3, pml = u.pm & 7;
        if (sec <= 1) {
            const float* gp = sec == 0 ? gq : gk; const float sc = sec == 0 ? C2 : 1.0f;
            f32x4 gv[2][2];
#pragma unroll
            for (int bj = 0; bj < 2; ++bj)
#pragma unroll
                for (int n = 0; n < 2; ++n) gv[bj][n] = *(const f32x4*)(gp + 32 * bj + 8 * fq + 4 * n) * sc;
            bf16_t* base = (sec == 0 ? Q : Kp) + (size_t)(((b * 8 + half * 4 + wc) * 16 + fr) * 128) * 64;
#pragma unroll
            for (int ai = 0; ai < 2; ++ai)
#pragma unroll
                for (int m = 0; m < 4; ++m) {
                    float s = 0.f;
#pragma unroll
                    for (int bj = 0; bj < 2; ++bj)
#pragma unroll
                        for (int n = 0; n < 2; ++n) { const f32x4 x = acc[ai][bj][m][n]; s += (x[0] * x[0] + x[1] * x[1]) + (x[2] * x[2] + x[3] * x[3]); }
                    s = xor16_32_sum(s);
                    const float r = __builtin_amdgcn_rsqf(s * (1.0f / 64.0f) + EPS);
                    const int i = 16 * pml + 8 * wr + 4 * ai + m;
#pragma unroll
                    for (int bj = 0; bj < 2; ++bj) {
                        const f32x4 v0 = acc[ai][bj][m][0] * r * gv[bj][0], v1 = acc[ai][bj][m][1] * r * gv[bj][1];
                        u32x4 w; w.x = pk2(v0[0], v0[1]); w.y = pk2(v0[2], v0[3]); w.z = pk2(v1[0], v1[1]); w.w = pk2(v1[2], v1[3]);
                        *(u32x4*)(base + (size_t)i * 64 + 32 * bj + 8 * fq) = w;
                    }
                }
        } else if (sec == 2) {
            bf16_t* base = Vt + (size_t)((((b * 8 + half * 4 + wc) * 16 + fr) * 16 + (2 * pml + wr)) * 64) * 8;
#pragma unroll
            for (int bj = 0; bj < 2; ++bj)
#pragma unroll
                for (int n = 0; n < 2; ++n)
#pragma unroll
                    for (int j = 0; j < 4; ++j) {
                        const int d = 32 * bj + 8 * fq + 4 * n + j;
                        u32x4 w;
                        w.x = pk2(acc[0][bj][0][n][j], acc[0][bj][1][n][j]); w.y = pk2(acc[0][bj][2][n][j], acc[0][bj][3][n][j]);
                        w.z = pk2(acc[1][bj][0][n][j], acc[1][bj][1][n][j]); w.w = pk2(acc[1][bj][2][n][j], acc[1][bj][3][n][j]);
                        *(u32x4*)(base + (size_t)d * 8) = w;
                    }
        } else {
            bf16_t* base = (sec == 3 ? U : G);
            const int col0 = 256 * half + 64 * wc + 8 * fq;
#pragma unroll
            for (int ai = 0; ai < 2; ++ai)
#pragma unroll
                for (int m = 0; m < 4; ++m) {
                    const size_t row = (size_t)u.pm * 256 + 128 * wr + 64 * ai + 16 * m + fr;
#pragma unroll
                    for (int bj = 0; bj < 2; ++bj) {
                        const f32x4 a0 = acc[ai][bj][m][0], a1 = acc[ai][bj][m][1];
                        u32x4 w; w.x = pk2(gelu_t(a0[0]), gelu_t(a0[1])); w.y = pk2(gelu_t(a0[2]), gelu_t(a0[3]));
                        w.z = pk2(gelu_t(a1[0]), gelu_t(a1[1])); w.w = pk2(gelu_t(a1[2]), gelu_t(a1[3]));
                        *(u32x4*)(base + row * 512 + col0 + 32 * bj) = w;
                    }
                }
        }
    }
};
struct EpiOut {
    static constexpr bool HEADPERM = false, MID = true;
    const float* x; bf16_t* XB; float* ssq; const float* ssqA;
    __device__ __forceinline__ void mid(f32x4 (&acc)[2][2][4][2], const Unit& u, int wr, int wc, int fr, int fq) const {
#pragma unroll
        for (int ai = 0; ai < 2; ++ai)
#pragma unroll
            for (int m = 0; m < 4; ++m) {
                const size_t row = (size_t)u.pm * 256 + 128 * wr + 64 * ai + 16 * m + fr;
                const f32x4* sp = (const f32x4*)(ssqA + row * 8);
                const f32x4 t = sp[0] + sp[1];
                const float r = __builtin_amdgcn_rsqf(((t[0] + t[1]) + (t[2] + t[3])) * (1.0f / AW) + EPS);
#pragma unroll
                for (int bj = 0; bj < 2; ++bj)
#pragma unroll
                    for (int n = 0; n < 2; ++n) acc[ai][bj][m][n] = acc[ai][bj][m][n] * r;
            }
    }
    __device__ __forceinline__ void operator()(const f32x4 (&acc)[2][2][4][2], const Unit& u, int wr, int wc, int fr, int fq) const {
#pragma unroll
        for (int ai = 0; ai < 2; ++ai)
#pragma unroll
            for (int m = 0; m < 4; ++m) {
                const size_t row = (size_t)u.pm * 256 + 128 * wr + 64 * ai + 16 * m + fr;
                const size_t off = row * DM + 256 * u.pn + 32 * wc + 8 * fq;
                float s = 0.f;
#pragma unroll
                for (int bj = 0; bj < 2; ++bj) {
                    const f32x4 v0 = *(const f32x4*)(x + off + 128 * bj) + acc[ai][bj][m][0], v1 = *(const f32x4*)(x + off + 128 * bj + 4) + acc[ai][bj][m][1];
                    s += (v0[0] * v0[0] + v0[1] * v0[1]) + (v0[2] * v0[2] + v0[3] * v0[3]) + (v1[0] * v1[0] + v1[1] * v1[1]) + (v1[2] * v1[2] + v1[3] * v1[3]);
                    u32x4 w; w.x = pk2(v0[0], v0[1]); w.y = pk2(v0[2], v0[3]); w.z = pk2(v1[0], v1[1]); w.w = pk2(v1[2], v1[3]);
                    *(u32x4*)(XB + off + 128 * bj) = w;
                }
                s = xor16_32_sum(s);
                if (fq == 0) ssq[row * 16 + u.pn * 4 + wc] = s;
            }
    }
};
struct EpiUp {
    static constexpr bool HEADPERM = false, MID = false;
    bf16_t* H; const float* ssq;
    __device__ __forceinline__ void operator()(const f32x4 (&acc)[2][2][4][2], const Unit& u, int wr, int wc, int fr, int fq) const {
#pragma unroll
        for (int ai = 0; ai < 2; ++ai)
#pragma unroll
            for (int m = 0; m < 4; ++m) {
                const size_t row = (size_t)u.pm * 256 + 128 * wr + 64 * ai + 16 * m + fr;
                const f32x4* sp = (const f32x4*)(ssq + row * 16);
                const f32x4 t = (sp[0] + sp[1]) + (sp[2] + sp[3]);
                const float r = __builtin_amdgcn_rsqf(((t[0] + t[1]) + (t[2] + t[3])) * (1.0f / DM) + EPS);
                const size_t off = (((size_t)u.pm * 64 + 4 * u.pn + (wc >> 1)) * 256 + (128 * wr + 64 * ai + 16 * m + fr)) * 64 + 32 * (wc & 1) + 8 * fq;
#pragma unroll
                for (int bj = 0; bj < 2; ++bj) {
                    f32x4 v0 = acc[ai][bj][m][0] * r, v1 = acc[ai][bj][m][1] * r;
#pragma unroll
                    for (int j = 0; j < 4; ++j) { v0[j] = fmaxf(v0[j], 0.f); v1[j] = fmaxf(v1[j], 0.f); }
                    v0 = v0 * v0; v1 = v1 * v1;
                    u32x4 w; w.x = pk2(v0[0], v0[1]); w.y = pk2(v0[2], v0[3]); w.z = pk2(v1[0], v1[1]); w.w = pk2(v1[2], v1[3]);
                    *(u32x4*)(H + off + (size_t)bj * (2 * 256 * 64)) = w;
                }
            }
    }
};
struct EpiDown {
    static constexpr bool HEADPERM = false, MID = false;
    float* out; const bf16_t* XB;
    __device__ __forceinline__ void operator()(const f32x4 (&acc)[2][2][4][2], const Unit& u, int wr, int wc, int fr, int fq) const {
#pragma unroll
        for (int ai = 0; ai < 2; ++ai)
#pragma unroll
            for (int m = 0; m < 4; ++m) {
                const size_t row = (size_t)u.pm * 256 + 128 * wr + 64 * ai + 16 * m + fr;
                const size_t off = row * DM + 256 * u.pn + 32 * wc + 8 * fq;
#pragma unroll
                for (int bj = 0; bj < 2; ++bj) {
                    const u32x4 xr = *(const u32x4*)(XB + off + 128 * bj);
                    f32x4 v0, v1;
                    v0[0] = __builtin_bit_cast(float, xr[0] << 16); v0[1] = __builtin_bit_cast(float, xr[0] & 0xffff0000u); v0[2] = __builtin_bit_cast(float, xr[1] << 16); v0[3] = __builtin_bit_cast(float, xr[1] & 0xffff0000u);
                    v1[0] = __builtin_bit_cast(float, xr[2] << 16); v1[1] = __builtin_bit_cast(float, xr[2] & 0xffff0000u); v1[2] = __builtin_bit_cast(float, xr[3] << 16); v1[3] = __builtin_bit_cast(float, xr[3] & 0xffff0000u);
                    *(f32x4*)(out + off + 128 * bj) = v0 + acc[ai][bj][m][0]; *(f32x4*)(out + off + 128 * bj + 4) = v1 + acc[ai][bj][m][1];
                }
            }
    }
};

template <class Epi, class Sched>
__device__ __forceinline__ void gemm_phase(LAS unsigned char* lds, const Gemm g, const Sched& S, const Epi& E) {
    int tid_ = threadIdx.x; asm volatile("" : "+v"(tid_));
    const int tid = tid_, wid = __builtin_amdgcn_readfirstlane(tid >> 6), lane = tid & 63, wr = wid >> 2, wc = wid & 3, fr = lane & 15, fq = lane >> 4;
    const int K = g.K, nt = K / BK;
    unsigned voffA[2], voffB[2];
#pragma unroll
    for (int i = 0; i < 2; ++i) { int R, C; stage_rc(tid * 16 + i * 8192, R, C);
        const int Ra = 128 * (R >> 6) + (R & 63);
        const int Rb = Epi::HEADPERM ? (64 * (R >> 5) + perm32(R & 31)) : ((R & ~31) + perm32(R & 31));
        voffA[i] = (unsigned)(Ra * g.lda + C) * 2u; voffB[i] = (unsigned)(Rb * K + C) * 2u; }
    const size_t kstep = (size_t)(BK * 2);
    const size_t hstepA = (size_t)64 * g.lda * 2, kstepA = (size_t)g.kstepA;
    const size_t hstepB = (size_t)(Epi::HEADPERM ? 32 : 128) * K * 2;
    const size_t tstep = (size_t)256 * K * 2;
    const unsigned ldsw = (unsigned)wid * 1024u;
    const unsigned lds_u32 = (unsigned)(size_t)lds;
    const int aoff = lds_byte(wr * 64 + fr, fq * 8), boff = lds_byte(wc * 32 + fr, fq * 8);
#define PG8_SA(b, h) (((b) * 2 + (h)) * HTB)
#define PG8_SB(b, h) ((4 + (b) * 2 + (h)) * HTB)
#define PG8_STAGE(bufoff, gbase, voff) do { _Pragma("unroll") for (int _i = 0; _i < 2; ++_i) { unsigned _keep; \
        const unsigned _ld = (unsigned)__builtin_amdgcn_readfirstlane((int)(lds_u32 + (unsigned)(bufoff) + ldsw + (unsigned)(_i * 8192))); \
        asm volatile("s_mov_b32 %0, m0\n\ts_mov_b32 m0, %2\n\ts_nop 0\n\tglobal_load_lds_dwordx4 %1, %3\n\ts_mov_b32 m0, %0" \
                     : "=&s"(_keep) : "v"((voff)[_i]), "s"(_ld), "s"((const char*)(gbase)) : "memory"); } } while (0)
#define PG8_LDA(dst, b, h) do { _Pragma("unroll") for (int m = 0; m < 4; ++m) _Pragma("unroll") for (int k = 0; k < 2; ++k) dst[m][k] = *(const LAS bf16x8*)(lds + PG8_SA(b, h) + aoff + m * 2048 + k * 1024); } while (0)
#define PG8_LDB(dst, b, h) do { _Pragma("unroll") for (int n = 0; n < 2; ++n) _Pragma("unroll") for (int k = 0; k < 2; ++k) dst[n][k] = *(const LAS bf16x8*)(lds + PG8_SB(b, h) + boff + n * 2048 + k * 1024); } while (0)
#define PG8_MMA(ai, bj, At, Bt) do { __builtin_amdgcn_s_setprio(1); _Pragma("unroll") for (int m = 0; m < 4; ++m) _Pragma("unroll") for (int n = 0; n < 2; ++n) _Pragma("unroll") for (int k = 0; k < 2; ++k) \
        acc[ai][bj][m][n] = __builtin_amdgcn_mfma_f32_16x16x32_bf16(Bt[n][k], At[m][k], acc[ai][bj][m][n], 0, 0, 0); __builtin_amdgcn_s_setprio(0); } while (0)
#define PG8_WAIT_V(n) asm volatile("s_waitcnt vmcnt(" #n ")" ::: "memory")
#define PG8_WAIT_L(n) asm volatile("s_waitcnt lgkmcnt(" #n ")" ::: "memory")
#define PG8_BAR __builtin_amdgcn_s_barrier()
#define PG8_SCHED __builtin_amdgcn_sched_barrier(0)
    Unit cur, nxt; int ui = 0;
    if (!S.next(0, cur)) return;
    f32x4 acc[2][2][4][2];
#pragma unroll
    for (int a = 0; a < 2; ++a)
#pragma unroll
        for (int b = 0; b < 2; ++b)
#pragma unroll
            for (int m = 0; m < 4; ++m)
#pragma unroll
                for (int n = 0; n < 2; ++n) acc[a][b][m][n] = (f32x4){0.f, 0.f, 0.f, 0.f};
    bf16x8 At[4][2], B0[2][2], B1[2][2];
    const char* cA = (const char*)g.A + (size_t)cur.pm * tstep; const char* cB = (const char*)g.Bt + (size_t)cur.pn * tstep;
    PG8_STAGE(PG8_SB(0, 0), cB, voffB); PG8_STAGE(PG8_SB(0, 1), cB + hstepB, voffB); PG8_STAGE(PG8_SA(0, 0), cA, voffA); PG8_STAGE(PG8_SA(0, 1), cA + hstepA, voffA);
    if (wr == 1) PG8_BAR;
    PG8_WAIT_V(2); PG8_BAR;
    PG8_STAGE(PG8_SB(1, 0), cB + kstep, voffB); PG8_STAGE(PG8_SA(1, 0), cA + kstepA, voffA); PG8_STAGE(PG8_SB(1, 1), cB + hstepB + kstep, voffB);
    PG8_WAIT_V(6); PG8_BAR;
    for (;;) {
        const bool has_next = S.next(ui + 1, nxt);
        const char* nA = has_next ? (const char*)g.A + (size_t)nxt.pm * tstep : cA; const char* nB = has_next ? (const char*)g.Bt + (size_t)nxt.pn * tstep : cB;
        for (int t = 0; t < nt; t += 2) {
            const bool last = (t == nt - 2);
            if constexpr (Epi::MID) { if (t == nt / 2) E.mid(acc, cur, wr, wc, fr, fq); }
            const char* a1 = cA + (size_t)(t + 1) * kstepA;
            const char* a2 = last ? nA : cA + (size_t)(t + 2) * kstepA; const char* b2 = last ? nB : cB + (size_t)(t + 2) * kstep;
            const char* a3 = a2 + kstepA; const char* b3 = b2 + kstep;
            PG8_LDB(B0, 0, 0); PG8_LDB(B1, 0, 1); PG8_SCHED; PG8_LDA(At, 0, 0); PG8_STAGE(PG8_SA(1, 1), a1 + hstepA, voffA);
            PG8_WAIT_V(8); PG8_WAIT_L(0); PG8_BAR; PG8_MMA(0, 0, At, B0); PG8_MMA(0, 1, At, B1); PG8_BAR; PG8_SCHED;
            PG8_LDA(At, 0, 1); PG8_STAGE(PG8_SB(0, 0), b2, voffB); PG8_STAGE(PG8_SB(0, 1), b2 + hstepB, voffB); PG8_STAGE(PG8_SA(0, 0), a2, voffA);
            PG8_WAIT_V(8); PG8_WAIT_L(0); PG8_BAR; PG8_MMA(1, 0, At, B0); PG8_MMA(1, 1, At, B1); PG8_BAR; PG8_SCHED;
            PG8_LDB(B0, 1, 0); PG8_LDB(B1, 1, 1); PG8_SCHED; PG8_LDA(At, 1, 0); PG8_STAGE(PG8_SA(0, 1), a2 + hstepA, voffA);
            PG8_WAIT_V(8); PG8_WAIT_L(0); PG8_BAR; PG8_MMA(0, 0, At, B0); PG8_MMA(0, 1, At, B1); PG8_BAR; PG8_SCHED;
            PG8_LDA(At, 1, 1); PG8_STAGE(PG8_SB(1, 0), b3, voffB); PG8_STAGE(PG8_SB(1, 1), b3 + hstepB, voffB); PG8_STAGE(PG8_SA(1, 0), a3, voffA);
            PG8_WAIT_V(8); PG8_WAIT_L(0); PG8_BAR; PG8_MMA(1, 0, At, B0); PG8_MMA(1, 1, At, B1); PG8_BAR; PG8_SCHED;
        }
        if (wr == 0) PG8_BAR;
        E(acc, cur, wr, wc, fr, fq);
        if (!has_next) break;
#pragma unroll
        for (int a = 0; a < 2; ++a)
#pragma unroll
            for (int b = 0; b < 2; ++b)
#pragma unroll
                for (int m = 0; m < 4; ++m)
#pragma unroll
                    for (int n = 0; n < 2; ++n) acc[a][b][m][n] = (f32x4){0.f, 0.f, 0.f, 0.f};
        cur = nxt; cA = nA; cB = nB; ++ui;
        if (wr == 1) PG8_BAR;
    }
    PG8_WAIT_V(0);
    PG8_BAR;
#undef PG8_SA
#undef PG8_SB
#undef PG8_STAGE
#undef PG8_LDA
#undef PG8_LDB
#undef PG8_MMA
#undef PG8_WAIT_V
#undef PG8_WAIT_L
#undef PG8_BAR
#undef PG8_SCHED
}
}

constexpr size_t MiB = 1u << 20;
constexpr size_t WS_WIN = 1 * MiB, WS_WOUT = 6 * MiB, WS_W1 = 8 * MiB, WS_W2 = 16 * MiB;
constexpr size_t WS_WSB = 27 * MiB;
constexpr size_t WS_SSQA = 26 * MiB;
constexpr size_t WS_SSQ = 24 * MiB;
constexpr size_t WS_XB = 32 * MiB;
constexpr size_t WS_Q = 96 * MiB, WS_K = 128 * MiB, WS_V = 160 * MiB, WS_U = 192 * MiB, WS_G = 224 * MiB, WS_MIX = 256 * MiB;
constexpr size_t WS_H = 96 * MiB;
constexpr size_t WS_END = 352 * MiB;
constexpr int LDS_BYTES = 157696, LDS_MISC = LDS_BYTES - 64;
constexpr size_t WS_CTL = 0, CTL_ZERO_BYTES = 16384;
constexpr int LDS_TT_PITCH = 272;
constexpr int LDS_SSQG = 4 * 128 * LDS_TT_PITCH;
constexpr int LDS_GG = LDS_SSQG + 2048;
constexpr int LDS_ATAB = 147456;
static_assert(LDS_ATAB + 64 * 144 <= LDS_BYTES - 64, "LDS map");

struct Args { const float* in[15]; float* out; unsigned char* ws; };

__device__ __forceinline__ void p0_transpose_item(const float* W, int K, int N, bf16_t* WT, const float* kscale, int klim, LAS float* scr, int item, int lane) {
    const int nblk = N / 32, kb = item / nblk, nb = item % nblk, k0 = 64 * kb, n0 = 32 * nb;
    float wv[32];
#pragma unroll
    for (int i = 0; i < 32; ++i) wv[i] = W[(size_t)(k0 + 2 * i + (lane >> 5)) * N + n0 + (lane & 31)];
#pragma unroll
    for (int i = 0; i < 32; ++i) { const int kk = 2 * i + (lane >> 5); float w = wv[i]; if (kscale && k0 + kk < klim) w *= kscale[k0 + kk]; scr[kk * 33 + (lane & 31)] = w; }
    asm volatile("s_waitcnt lgkmcnt(0)" ::: "memory");
    const int c = lane & 7;
#pragma unroll
    for (int j = 0; j < 4; ++j) { const int n = (lane >> 3) + 8 * j; const LAS float* s = scr + (8 * c) * 33 + n;
        u32x4 o; o.x = pk2(s[0 * 33], s[1 * 33]); o.y = pk2(s[2 * 33], s[3 * 33]); o.z = pk2(s[4 * 33], s[5 * 33]); o.w = pk2(s[6 * 33], s[7 * 33]);
        *(u32x4*)(WT + (size_t)(n0 + n) * K + k0 + 8 * c) = o; }
    asm volatile("s_waitcnt lgkmcnt(0)" ::: "memory");
}
__device__ __forceinline__ void rms_rows4_to_bf16(const float* x, const float* gain, bf16_t* o, size_t m0, size_t stride, int lane) {
    f32x4 v[4][4];
#pragma unroll
    for (int r = 0; r < 4; ++r) { const f32x4* xr = (const f32x4*)(x + (m0 + r * stride) * DM) + lane;
#pragma unroll
        for (int j = 0; j < 4; ++j) v[r][j] = xr[64 * j]; }
    f32x4 gr[4];
#pragma unroll
    for (int j = 0; j < 4; ++j) gr[j] = ((const f32x4*)gain + lane)[64 * j];
#pragma unroll
    for (int r = 0; r < 4; ++r) {
        float s = 0.f;
#pragma unroll
        for (int j = 0; j < 4; ++j) s += (v[r][j][0] * v[r][j][0] + v[r][j][1] * v[r][j][1]) + (v[r][j][2] * v[r][j][2] + v[r][j][3] * v[r][j][3]);
        const float rstd = __builtin_amdgcn_rsqf(wave_sum(s) * (1.f / DM) + EPS);
        u32x2* o8 = (u32x2*)(o + (m0 + r * stride) * DM) + lane;
#pragma unroll
        for (int j = 0; j < 4; ++j) { const f32x4 y = v[r][j] * rstd * gr[j]; u32x2 w; w.x = pk2(y[0], y[1]); w.y = pk2(y[2], y[3]); o8[64 * j] = w; }
    }
}

constexpr int KC_PITCH = 160, LDS_KC = 0, LDS_VC = 16 * 32 * KC_PITCH;
static_assert(LDS_VC + 65536 <= LDS_ATAB, "attention LDS: K image | V image | multiplicity tables (the gMLP scratch overlays the images: different units, barrier-separated)");
__device__ __forceinline__ void run_desc(int tt, int g, int c, int R0, int& cg, int& Rg) {
    if (tt < 4) { cg = c; Rg = R0 - 16 + 4 * tt + g; }
    else if (tt < 7) { cg = (c + 4 * (tt - 3)) & 15; Rg = R0 - 4 + g; }
    else if (tt < 10) { const int o = 4 * (tt - 7) + g; const int o3 = (o * 11) >> 5; cg = (c + 1 + o3 * 4 + (o - 3 * o3)) & 15; Rg = R0 - 1; }
    else { cg = tt - 10; Rg = R0 + g; }
}
__device__ __forceinline__ bool tile_valid(int tt, int R0) {
    if (tt < 4) return R0 - 16 + 4 * tt >= 0;
    if (tt < 7) return R0 >= 4;
    if (tt < 10) return R0 >= 1;
    return true;
}
__device__ __forceinline__ int next_tile(int tt, int R0) { while (tt < 26 && !tile_valid(tt, R0)) ++tt; return tt; }

struct AttnP { const bf16_t *Q, *K, *Vt; bf16_t* MIX; float* ssqA; const float *gq, *gk; };

__device__ __forceinline__ void attn_load_k(const AttnP& P, LAS unsigned char* lds, int hb, int tt, int c, int R0, int lane, bf16x8 (&kf)[4]) {
    const int rho = lane & 31, h = lane >> 5;
    const int gk_ = 2 * (rho >> 4) + ((rho >> 2) & 1), pk_ = 4 * ((rho >> 3) & 1) + (rho & 3);
    if (tt < 10) {
        int cg, Rg; run_desc(tt, gk_, c, R0, cg, Rg);
        const bf16_t* kp = P.K + ((size_t)(hb * 16 + cg) * 128 + 8 * Rg + pk_) * 64 + 8 * h;
#pragma unroll
        for (int kk = 0; kk < 4; ++kk) kf[kk] = *(const bf16x8*)(kp + 16 * kk);
    } else {
        const LAS unsigned char* kp = lds + LDS_KC + ((tt - 10) * 32 + 8 * gk_ + pk_) * KC_PITCH + 16 * h;
#pragma unroll
        for (int kk = 0; kk < 4; ++kk) kf[kk] = *(const LAS bf16x8*)(kp + 32 * kk);
    }
}
__device__ __forceinline__ void attn_load_v(const AttnP& P, LAS unsigned char* lds, int hb, int tt, int c, int R0, int lane, bf16x8 (&vf)[2][2]) {
    const int rho = lane & 31, h = lane >> 5;
    if (tt < 10) {
#pragma unroll
        for (int s = 0; s < 2; ++s) { int cg, Rg; run_desc(tt, 2 * s + h, c, R0, cg, Rg);
            const bf16_t* vp = P.Vt + ((size_t)((hb * 16 + cg) * 16 + Rg) * 64 + rho) * 8;
            vf[0][s] = *(const bf16x8*)(vp); vf[1][s] = *(const bf16x8*)(vp + 32 * 8); }
    } else {
#pragma unroll
        for (int s = 0; s < 2; ++s) { const LAS unsigned char* vp = lds + LDS_VC + (((tt - 10) * 4 + 2 * s + h) * 64 + rho) * 16;
            vf[0][s] = *(const LAS bf16x8*)(vp); vf[1][s] = *(const LAS bf16x8*)(vp + 512); }
    }
}

__device__ __forceinline__ unsigned long long mult_bytes(int D0, int T2, int T3) {
    const unsigned long long ONES = 0x0101010101010101ull;
    const int l1 = max((D0 - 128 + 15) >> 4, 0), l2 = max((D0 - T2 + 15) >> 4, 0), l3 = max((D0 - T3 + 15) >> 4, 0);
    const unsigned long long w = (l1 >= 8 ? 0ull : (ONES << (8 * l1))) + (l2 >= 8 ? 0ull : (ONES << (8 * l2))) + (l3 >= 8 ? 0ull : (ONES << (8 * l3)));
    const int hi = D0 >> 4;
    const unsigned long long mh = hi < 0 ? 0ull : (hi >= 7 ? ~0ull : ((1ull << (8 * (hi + 1))) - 1ull));
    return w & mh;
}

__device__ __forceinline__ void attn_tables(int lane, unsigned long long (&T)[18]) {
    const int q = lane & 31, h = lane >> 5;
#pragma unroll
    for (int eg = 0; eg < 2; ++eg) { const int u16 = 16 * (q - 8 * (2 * eg + h)), g = 2 * eg + h;
        T[0 + eg] = mult_bytes(u16 + 1, 4096, -1) - mult_bytes(u16 + 1, -1, -1);
        T[2 + eg] = mult_bytes(u16 - 1, 4096, -1) - mult_bytes(u16 - 1, -1, -1);
        T[4 + eg] = mult_bytes(u16 + 1, -1, -1); T[6 + eg] = mult_bytes(u16 - 1, -1, -1);
        T[8 + eg] = mult_bytes(16 * (q + 128 - 8 * g), 512, 2048); T[10 + eg] = mult_bytes(16 * (q + 32 - 8 * g), 512, 2048);
        T[12 + eg] = mult_bytes(4 + 16 * (q + 32 - 8 * g), 512, -1); T[14 + eg] = mult_bytes(-4 + 16 * (q + 32 - 8 * g), 512, -1); }
    T[16] = mult_bytes(1 + 16 * (q + 8), -1, -1); T[17] = mult_bytes(-1 + 16 * (q + 8), -1, -1);
}

__device__ __forceinline__ void tile_compute(const bf16x8 (&kf)[4], const bf16x8 (&vf)[2][2], const bf16x8 (&qf)[4], unsigned long long w0, unsigned long long w1,
                                             float shift, f32x16& o0, f32x16& o1, f32x16& zacc) {
    f32x16 st = {};
#pragma unroll
    for (int kk = 0; kk < 4; ++kk) st = __builtin_amdgcn_mfma_f32_32x32x16_bf16(kf[kk], qf[kk], st, 0, 0, 0);
    if (__builtin_amdgcn_readfirstlane(__builtin_bit_cast(int, shift)) != 0) {
        asm volatile("" ::: "memory");
#pragma unroll
        for (int e = 0; e < 16; ++e) st[e] -= shift;
    }
    unsigned pw[8];
#pragma unroll
    for (int eg = 0; eg < 2; ++eg) {
        const unsigned long long w = eg ? w1 : w0;
        const unsigned wl = (unsigned)w, wh = (unsigned)(w >> 32);
        float pv[8];
#pragma unroll
        for (int p = 0; p < 4; ++p) {
            pv[p] = (float)((wl >> (8 * p)) & 0xffu) * __builtin_amdgcn_exp2f(st[8 * eg + p]);
            pv[4 + p] = (float)((wh >> (8 * p)) & 0xffu) * __builtin_amdgcn_exp2f(st[8 * eg + 4 + p]);
        }
#pragma unroll
        for (int p = 0; p < 4; ++p) pw[4 * eg + p] = pk2(pv[2 * p], pv[2 * p + 1]);
    }
    const bf16x8 ones = {0x3F80, 0x3F80, 0x3F80, 0x3F80, 0x3F80, 0x3F80, 0x3F80, 0x3F80};
    const bf16x8 pf0 = __builtin_bit_cast(bf16x8, (u32x4){pw[0], pw[1], pw[2], pw[3]});
    const bf16x8 pf1 = __builtin_bit_cast(bf16x8, (u32x4){pw[4], pw[5], pw[6], pw[7]});
    o0 = __builtin_amdgcn_mfma_f32_32x32x16_bf16(vf[0][0], pf0, o0, 0, 0, 0);
    o1 = __builtin_amdgcn_mfma_f32_32x32x16_bf16(vf[1][0], pf0, o1, 0, 0, 0);
    zacc = __builtin_amdgcn_mfma_f32_32x32x16_bf16(ones, pf0, zacc, 0, 0, 0);
    o0 = __builtin_amdgcn_mfma_f32_32x32x16_bf16(vf[0][1], pf1, o0, 0, 0, 0);
    o1 = __builtin_amdgcn_mfma_f32_32x32x16_bf16(vf[1][1], pf1, o1, 0, 0, 0);
    zacc = __builtin_amdgcn_mfma_f32_32x32x16_bf16(ones, pf1, zacc, 0, 0, 0);
}

__device__ __forceinline__ void attn_task(const AttnP& P, LAS unsigned char* lds, int b, int hd, int qq, int c, float shift, int lane_in) {
    int lane = lane_in; asm volatile("" : "+v"(lane));
    const int hb = b * 8 + hd, q = lane & 31, h = lane >> 5, R0 = 4 * qq, iq0 = 32 * qq;
    bf16x8 qf[4];
    { const bf16_t* qp = P.Q + ((size_t)(hb * 16 + c) * 128 + iq0 + q) * 64 + 8 * h;
#pragma unroll
      for (int kk = 0; kk < 4; ++kk) qf[kk] = *(const bf16x8*)(qp + 16 * kk); }
    bf16x8 gk[4];
    int gi = next_tile(0, R0);
    if (gi < 10) attn_load_k(P, lds, hb, gi, c, R0, lane, gk);
    unsigned long long Hp[2], Hn[2], Bp[2], Bn[2], mT0[2], mT3[2], mAp[2], mAn[2], mLp, mLn;
    { const LAS unsigned long long* T = (const LAS unsigned long long*)(lds + LDS_ATAB + lane * 144);
      Hp[0] = T[0]; Hp[1] = T[1]; Hn[0] = T[2]; Hn[1] = T[3]; Bp[0] = T[4]; Bp[1] = T[5]; Bn[0] = T[6]; Bn[1] = T[7];
      mT0[0] = T[8]; mT0[1] = T[9]; mT3[0] = T[10]; mT3[1] = T[11]; mAp[0] = T[12]; mAp[1] = T[13]; mAn[0] = T[14]; mAn[1] = T[15]; mLp = T[16]; mLn = T[17]; }
    f32x16 o0 = {}, o1 = {}, zacc = {};
    int li = 10, ph = 0;
#pragma clang loop unroll(disable)
    while (li < 26 || gi < 10) {
        bf16x8 kf[4], vf[2][2];
        unsigned long long w0, w1;
        if (gi < 10 && (ph >= 2 || li >= 26)) {
            attn_load_v(P, lds, hb, gi, c, R0, lane, vf);
#pragma unroll
            for (int kk = 0; kk < 4; ++kk) kf[kk] = gk[kk];
            if (gi < 4) {
                if (gi == 0) { w0 = mT0[0]; w1 = mT0[1]; } else if (gi == 3) { w0 = mT3[0]; w1 = mT3[1]; } else { w0 = 0x0101010101010101ull; w1 = 0x0101010101010101ull; }
            } else if (gi < 7) {
                const bool pos = c > ((c + 4 * (gi - 3)) & 15);
                w0 = pos ? mAp[0] : mAn[0]; w1 = pos ? mAp[1] : mAn[1];
            } else {
                { int cg, Rg; run_desc(gi, h, c, R0, cg, Rg); w0 = (c > cg) ? mLp : mLn; }
                { int cg, Rg; run_desc(gi, 2 + h, c, R0, cg, Rg); w1 = (c > cg) ? mLp : mLn; }
            }
            gi = next_tile(gi + 1, R0);
            if (gi < 10) attn_load_k(P, lds, hb, gi, c, R0, lane, gk);
            ph = 0;
        } else {
            attn_load_k(P, lds, hb, li, c, R0, lane, kf); attn_load_v(P, lds, hb, li, c, R0, lane, vf);
            const int dl = c - (li - 10);
            if (dl == 0) { w0 = 3 * Hp[0] - Hn[0] + Bn[0]; w1 = 3 * Hp[1] - Hn[1] + Bn[1]; }
            else if (dl > 0) { const unsigned long long m = ((dl & 3) == 0) ? ~0ull : 0ull; w0 = Bp[0] + (Hp[0] & m); w1 = Bp[1] + (Hp[1] & m); }
            else { const unsigned long long m = ((dl & 3) == 0) ? ~0ull : 0ull; w0 = Bn[0] + (Hn[0] & m); w1 = Bn[1] + (Hn[1] & m); }
            ++li; ++ph;
        }
        tile_compute(kf, vf, qf, w0, w1, shift, o0, o1, zacc);
    }
    const float rz = __builtin_amdgcn_rcpf(zacc[0]);
    float ss = 0.f;
#pragma unroll
    for (int e = 0; e < 16; ++e) { o0[e] *= rz; o1[e] *= rz; ss += o0[e] * o0[e] + o1[e] * o1[e]; }
    ss = xor32_sum(ss);
    const size_t tok = (size_t)b * SEQ + c + 16 * (iq0 + q);
    if (h == 0) P.ssqA[tok * 8 + hd] = ss;
    bf16_t* orow = P.MIX + tok * DM + hd * 64;
#pragma unroll
    for (int e4 = 0; e4 < 4; ++e4) {
        const int d0 = 8 * e4 + 4 * h;
        u32x2 w0, w1;
        w0.x = pk2(o0[4 * e4], o0[4 * e4 + 1]); w0.y = pk2(o0[4 * e4 + 2], o0[4 * e4 + 3]);
        w1.x = pk2(o1[4 * e4], o1[4 * e4 + 1]); w1.y = pk2(o1[4 * e4 + 2], o1[4 * e4 + 3]);
        *(u32x2*)(orow + d0) = w0; *(u32x2*)(orow + 32 + d0) = w1;
    }
}

__device__ __forceinline__ void attn_unit(const AttnP& P, LAS unsigned char* lds, int b, int hd, int qq, int wave, int lane) {
    int tid_ = threadIdx.x; asm volatile("" : "+v"(tid_));
    const int hb = b * 8 + hd, tid = tid_;
    float shift;
    { const float mq = wave_max(fabsf(P.gq[lane])), mk = wave_max(fabsf(P.gk[lane])); shift = fminf(8.0f * mq * mk * 1.4426950408889634f, 64.0f); shift = shift > 30.0f ? shift : 0.f; }
    {
        u32x4 kr[8], vr[8];
#pragma unroll
        for (int j = 0; j < 8; ++j) { const int chunk = tid + 512 * j, row = chunk >> 3, piece = chunk & 7, cls = row >> 5, il = row & 31;
            kr[j] = *(const u32x4*)(P.K + ((size_t)(hb * 16 + cls) * 128 + 32 * qq + il) * 64 + piece * 8); }
#pragma unroll
        for (int j = 0; j < 8; ++j) { const int chunk = tid + 512 * j, cls = chunk >> 8, within = chunk & 255;
            vr[j] = *(const u32x4*)(P.Vt + ((size_t)(hb * 16 + cls) * 16 + 4 * qq) * 512 + within * 8); }
        __syncthreads();
#pragma unroll
        for (int j = 0; j < 8; ++j) { const int chunk = tid + 512 * j, row = chunk >> 3, piece = chunk & 7;
            *(LAS u32x4*)(lds + LDS_KC + row * KC_PITCH + piece * 16) = kr[j]; }
#pragma unroll
        for (int j = 0; j < 8; ++j) { const int chunk = tid + 512 * j; *(LAS u32x4*)(lds + LDS_VC + chunk * 16) = vr[j]; }
    }
    __syncthreads();
    attn_task(P, lds, b, hd, qq, wave, shift, lane);
    attn_task(P, lds, b, hd, qq, wave + 8, shift, lane);
}

struct GmlpP { const bf16_t *U, *G; bf16_t* MIX; const float *lng, *lnb; const bf16_t* wsb; const float *bs, *go; };
__device__ __forceinline__ void gmlp_unit(const GmlpP& P, int b, int ch, LAS unsigned char* lds, int wave, int lane_in) {
    int lane = lane_in; asm volatile("" : "+v"(lane));
    const size_t tok0 = (size_t)b * SEQ + (size_t)ch * 128;
    const int gI = wave >> 1, th = wave & 1;
    {
        const int sub = lane & 15, rr = lane >> 4;
        const f32x4 ga0 = *(const f32x4*)(P.lng + gI * 128 + 8 * sub), ga1 = *(const f32x4*)(P.lng + gI * 128 + 8 * sub + 4);
        const f32x4 be0 = *(const f32x4*)(P.lnb + gI * 128 + 8 * sub), be1 = *(const f32x4*)(P.lnb + gI * 128 + 8 * sub + 4);
        u32x4 rawv[16];
#pragma unroll
        for (int it = 0; it < 16; ++it) rawv[it] = *(const u32x4*)(P.G + (tok0 + 64 * th + 16 * rr + it) * GW + gI * 128 + 8 * sub);
        const f32x4 gstage = (threadIdx.x < 128) ? *(const f32x4*)(P.go + (threadIdx.x & 127) * 4) : (f32x4){0.f, 0.f, 0.f, 0.f};
        __syncthreads();
        if (threadIdx.x < 128) *(LAS f32x4*)(lds + LDS_GG + threadIdx.x * 16) = gstage;
#pragma unroll
        for (int hf = 0; hf < 2; ++hf) {
            float yv[8][8];
#pragma unroll
            for (int i = 0; i < 8; ++i) {
                const u32x4 raw = rawv[8 * hf + i];
                float v[8];
#pragma unroll
                for (int j = 0; j < 4; ++j) { v[2 * j] = __builtin_bit_cast(float, raw[j] << 16); v[2 * j + 1] = __builtin_bit_cast(float, raw[j] & 0xffff0000u); }
                float sm = 0.f;
#pragma unroll
                for (int j = 0; j < 8; ++j) sm += v[j];
                sm = row16_sum(sm);
                const float mu = sm * (1.0f / 128.0f);
                float sq = 0.f;
#pragma unroll
                for (int j = 0; j < 8; ++j) { v[j] -= mu; sq += v[j] * v[j]; }
                sq = row16_sum(sq);
                const float rs = __builtin_amdgcn_rsqf(sq * (1.0f / 128.0f) + EPS);
#pragma unroll
                for (int j = 0; j < 8; ++j) yv[j][i] = v[j] * rs * (j < 4 ? ga0[j & 3] : ga1[j & 3]) + (j < 4 ? be0[j & 3] : be1[j & 3]);
            }
            const int s0 = 64 * th + 16 * rr + 8 * hf;
            LAS unsigned char* dst = lds + (gI * 128 + 8 * sub) * LDS_TT_PITCH + 16 * ((s0 >> 3) ^ sub);
#pragma unroll
            for (int j = 0; j < 8; ++j) {
                u32x4 w; w.x = pk2(yv[j][0], yv[j][1]); w.y = pk2(yv[j][2], yv[j][3]); w.z = pk2(yv[j][4], yv[j][5]); w.w = pk2(yv[j][6], yv[j][7]);
                *(LAS u32x4*)(dst + j * LDS_TT_PITCH) = w;
            }
            asm volatile("" ::: "memory");
        }
    }
    const int r32 = lane & 31, h = lane >> 5;
    const int tt0 = th, tt1 = 3 - th;
    bf16x8 bw0[4], bw1[8];
    { const bf16_t* w0p = P.wsb + ((size_t)(gI * 128 + 32 * tt0 + r32) * 128 + 8 * h);
      const bf16_t* w1p = P.wsb + ((size_t)(gI * 128 + 32 * tt1 + r32) * 128 + 8 * h);
#pragma unroll
      for (int ks = 0; ks < 4; ++ks) bw0[ks] = *(const bf16x8*)(w0p + 16 * ks);
#pragma unroll
      for (int ks = 0; ks < 8; ++ks) bw1[ks] = *(const bf16x8*)(w1p + 16 * ks); }
    __syncthreads();
    f32x16 acc[4][2];
#pragma unroll
    for (int mt = 0; mt < 4; ++mt) { acc[mt][0] = (f32x16){}; acc[mt][1] = (f32x16){}; }
    {
#pragma unroll
        for (int ks = 0; ks < 8; ++ks)
#pragma unroll
            for (int mt = 0; mt < 4; ++mt) {
                const int cc = 32 * mt + r32;
                const bf16x8 a = *(const LAS bf16x8*)(lds + (gI * 128 + cc) * LDS_TT_PITCH + 16 * ((2 * ks + h) ^ ((cc >> 3) & 15)));
                if (ks < 4) acc[mt][0] = __builtin_amdgcn_mfma_f32_32x32x16_bf16(a, bw0[ks], acc[mt][0], 0, 0, 0);
                acc[mt][1] = __builtin_amdgcn_mfma_f32_32x32x16_bf16(a, bw1[ks], acc[mt][1], 0, 0, 0);
                if (mt == 3 && (ks & 1)) asm volatile("" ::: "memory");
            }
    }
    LAS float* ssqg = (LAS float*)(lds + LDS_SSQG);
#pragma unroll
    for (int nt = 0; nt < 2; ++nt) {
        const int t = 32 * (nt == 0 ? tt0 : tt1) + r32;
        const float bsv = P.bs[gI * 128 + t];
        const bf16_t* up = P.U + (tok0 + t) * GW + gI * 128 + 4 * h;
        float ss = 0.f;
        u32x2 uraw[4][4];
#pragma unroll
        for (int mt = 0; mt < 4; ++mt)
#pragma unroll
            for (int e4 = 0; e4 < 4; ++e4) uraw[mt][e4] = *(const u32x2*)(up + 32 * mt + 8 * e4);
#pragma unroll
        for (int mt = 0; mt < 4; ++mt)
#pragma unroll
            for (int e4 = 0; e4 < 4; ++e4) {
                const u32x2 raw = uraw[mt][e4];
                const float u0 = __builtin_bit_cast(float, raw.x << 16), u1 = __builtin_bit_cast(float, raw.x & 0xffff0000u);
                const float u2 = __builtin_bit_cast(float, raw.y << 16), u3 = __builtin_bit_cast(float, raw.y & 0xffff0000u);
                float m0 = u0 * (acc[mt][nt][4 * e4] + bsv), m1 = u1 * (acc[mt][nt][4 * e4 + 1] + bsv), m2 = u2 * (acc[mt][nt][4 * e4 + 2] + bsv), m3 = u3 * (acc[mt][nt][4 * e4 + 3] + bsv);
                acc[mt][nt][4 * e4] = m0; acc[mt][nt][4 * e4 + 1] = m1; acc[mt][nt][4 * e4 + 2] = m2; acc[mt][nt][4 * e4 + 3] = m3;
                ss += (m0 * m0 + m1 * m1) + (m2 * m2 + m3 * m3);
            }
        ss = xor32_sum(ss);
        if (h == 0) ssqg[gI * 128 + t] = ss;
    }
    __syncthreads();
#pragma unroll
    for (int nt = 0; nt < 2; ++nt) {
        const int t = 32 * (nt == 0 ? tt0 : tt1) + r32;
        const float tot = (ssqg[t] + ssqg[128 + t]) + (ssqg[256 + t] + ssqg[384 + t]);
        const float r = __builtin_amdgcn_rsqf(tot * (1.0f / GW) + EPS);
        bf16_t* op = P.MIX + (tok0 + t) * DM + AW + gI * 128 + 4 * h;
#pragma unroll
        for (int mt = 0; mt < 4; ++mt)
#pragma unroll
            for (int e4 = 0; e4 < 4; ++e4) {
                const f32x4 gg = *(const LAS f32x4*)(lds + LDS_GG + (gI * 128 + 32 * mt + 8 * e4 + 4 * h) * 4);
                u32x2 w; w.x = pk2(acc[mt][nt][4 * e4] * r * gg[0], acc[mt][nt][4 * e4 + 1] * r * gg[1]); w.y = pk2(acc[mt][nt][4 * e4 + 2] * r * gg[2], acc[mt][nt][4 * e4 + 3] * r * gg[3]);
                *(u32x2*)(op + 32 * mt + 8 * e4) = w;
            }
    }
}

typedef __attribute__((address_space(1))) unsigned gu32;
#define XB_TMO      128
#define XB_XCNT(j)  (256  + 64 * (j))
#define XB_XSUB(j)  (1280 + 64 * (j))
#define XB_XGEN(j)  (2304 + 64 * (j))
#define XB_TOP      3328
#define XB_TOPGEN   3392
#define XCD_BAR_WORDS 3456
#define XB_SPIN_CAP (1u << 18)
__device__ __forceinline__ unsigned xb_ld(unsigned* p)              { return __hip_atomic_load(p, __ATOMIC_RELAXED, __HIP_MEMORY_SCOPE_AGENT); }
__device__ __forceinline__ unsigned xb_add(unsigned* p, unsigned v) { return __hip_atomic_fetch_add(p, v, __ATOMIC_RELAXED, __HIP_MEMORY_SCOPE_AGENT); }
__device__ __forceinline__ unsigned xb_xcc_id() { return (unsigned)__builtin_amdgcn_s_getreg((3 << 11) | 20) & 0xFu; }
#define XB_SPIN(cond, bar) do { unsigned _sp = 0; while (cond) { __builtin_amdgcn_s_sleep(1); \
    if ((++_sp & 255u) == 0u) { if (xb_ld(&(bar)[XB_TMO])) break; if (_sp > XB_SPIN_CAP) { atomicAdd(&(bar)[XB_TMO], 1u); break; } } } } while (0)
struct XcdBarrier { unsigned* bar; unsigned x; volatile LAS unsigned* st; };
__device__ __forceinline__ XcdBarrier xcd_barrier_post(unsigned* bar, volatile LAS unsigned* st) {
    XcdBarrier b; b.bar = bar; b.x = xb_xcc_id(); b.st = st;
    if (threadIdx.x == 0) (void)xb_add(&bar[XB_XCNT(b.x)], 1u);
    return b;
}
__device__ __forceinline__ void xcd_barrier_complete(unsigned* bar, unsigned x, unsigned& nloc, unsigned& nx) {
    const unsigned G = gridDim.x * gridDim.y * gridDim.z;
    unsigned sum, cnt, mine, sp = 0u;
    for (;;) {
        sum = 0u; cnt = 0u; mine = 0u;
#pragma unroll
        for (unsigned j = 0; j < 16; ++j) { const unsigned c = xb_ld(&bar[XB_XCNT(j)]); sum += c; cnt += (c > 0u) ? 1u : 0u; mine = (j == x) ? c : mine; }
        if (sum == G) break;
        __builtin_amdgcn_s_sleep(1);
        if ((++sp & 255u) == 0u) { if (xb_ld(&bar[XB_TMO])) break; if (sp > XB_SPIN_CAP) { atomicAdd(&bar[XB_TMO], 1u); break; } }
    }
    nloc = mine > 0u ? mine : 1u; nx = cnt > 0u ? cnt : 1u;
}
__device__ __forceinline__ void xcd_barrier(const XcdBarrier& b) {
    asm volatile("s_waitcnt vmcnt(0)" ::: "memory");
    __syncthreads();
    if (threadIdx.x == 0) {
        unsigned* bar = b.bar;
        __builtin_amdgcn_s_waitcnt(0);
        unsigned nloc = b.st[0], nx = b.st[1];
        if (nloc == 0u) { xcd_barrier_complete(bar, b.x, nloc, nx); b.st[0] = nloc; b.st[1] = nx; }
        const unsigned old = xb_add(&bar[XB_XSUB(b.x)], 1u);
        const unsigned gen = old / nloc;
        if (old + 1u == (gen + 1u) * nloc) {
            __builtin_amdgcn_fence(__ATOMIC_RELEASE, "agent");
            asm volatile("s_waitcnt vmcnt(0)" ::: "memory");
            const unsigned og = xb_add(&bar[XB_TOP], 1u);
            const unsigned tg = og / nx;
            if (og + 1u == (tg + 1u) * nx) xb_add(&bar[XB_TOPGEN], 1u);
            else XB_SPIN(xb_ld(&bar[XB_TOPGEN]) == tg, bar);
            __builtin_amdgcn_fence(__ATOMIC_ACQUIRE, "agent");
            xb_add(&bar[XB_XGEN(b.x)], 1u);
            asm volatile("s_waitcnt vmcnt(0)" ::: "memory");
        } else {
            XB_SPIN(xb_ld(&bar[XB_XGEN(b.x)]) == gen, bar);
            __builtin_amdgcn_fence(__ATOMIC_ACQUIRE, "agent");
            asm volatile("s_waitcnt vmcnt(0)" ::: "memory");
        }
    }
    __syncthreads();
}

#ifndef REP_P0
#define REP_P0 1
#endif
#ifndef REP_P1
#define REP_P1 1
#endif
#ifndef REP_P2
#define REP_P2 1
#endif
#ifndef REP_GM
#define REP_GM 1
#endif
#ifndef REP_P3
#define REP_P3 1
#endif
#ifndef REP_P4
#define REP_P4 1
#endif
__global__ void __launch_bounds__(512, 2) mk_fwd(Args args) {
    extern __shared__ __attribute__((aligned(16))) unsigned char lds_raw[];
    LAS unsigned char* lds = (LAS unsigned char*)lds_raw;
    const int tid = threadIdx.x, lane = tid & 63, wave = __builtin_amdgcn_readfirstlane(tid >> 6);
    const int G = gridDim.x, bx = blockIdx.x;
    unsigned char* ws = args.ws;
    const float* x = args.in[0]; const float* norm1_g = args.in[1]; const float* w_in = args.in[2]; const float* q_norm_g = args.in[3]; const float* k_norm_g = args.in[4];
    const float* ln_v_g = args.in[5]; const float* ln_v_b = args.in[6]; const float* w_sp = args.in[7]; const float* b_sp = args.in[8];
    const float* attn_out_g = args.in[9]; const float* gmlp_out_g = args.in[10]; const float* w_out = args.in[11]; const float* norm2_g = args.in[12];
    const float* w_ff1 = args.in[13]; const float* w_ff2 = args.in[14];
    float* out = args.out;
    bf16_t* Win_t = (bf16_t*)(ws + WS_WIN); bf16_t* Wout_t = (bf16_t*)(ws + WS_WOUT); bf16_t* W1_t = (bf16_t*)(ws + WS_W1); bf16_t* W2_t = (bf16_t*)(ws + WS_W2);
    float* ssq = (float*)(ws + WS_SSQ); float* ssqA = (float*)(ws + WS_SSQA); bf16_t* Wsb = (bf16_t*)(ws + WS_WSB);
    bf16_t* XB = (bf16_t*)(ws + WS_XB); bf16_t* Qb = (bf16_t*)(ws + WS_Q); bf16_t* Kb = (bf16_t*)(ws + WS_K); bf16_t* Vt = (bf16_t*)(ws + WS_V);
    bf16_t* Ub = (bf16_t*)(ws + WS_U); bf16_t* Gb = (bf16_t*)(ws + WS_G); bf16_t* MIX = (bf16_t*)(ws + WS_MIX); bf16_t* Hb = (bf16_t*)(ws + WS_H);

    volatile LAS unsigned* MISC = (volatile LAS unsigned*)(lds + LDS_MISC);
    if (tid < 16) MISC[tid] = 0u;
    __syncthreads();
    const XcdBarrier bar = xcd_barrier_post((unsigned*)(ws + WS_CTL), MISC);
#ifndef SKIP_P0
    {
        LAS float* scr = (LAS float*)(lds + wave * 16384);
        const int gw = bx * 8 + wave, NGW = G * 8;
        constexpr int I_IN = (DM / 64) * (NIN / 32), I_OUT = (DM / 64) * (DM / 32), I_1 = (DM / 64) * (FF / 32), I_2 = (FF / 64) * (DM / 32);
        constexpr int NITEMS = I_IN + I_OUT + I_1 + I_2;
        for (int it = gw; it < NITEMS; it += NGW) {
            int r = it;
            if (r < I_IN) { p0_transpose_item(w_in, DM, NIN, Win_t, nullptr, 0, scr, r, lane); continue; } r -= I_IN;
            if (r < I_OUT) { p0_transpose_item(w_out, DM, DM, Wout_t, attn_out_g, AW, scr, r, lane); continue; } r -= I_OUT;
            if (r < I_1) { p0_transpose_item(w_ff1, DM, FF, W1_t, norm2_g, DM, scr, r, lane); continue; } r -= I_1;
            p0_transpose_item(w_ff2, FF, DM, W2_t, nullptr, 0, scr, r, lane);
        }
        for (int e = (bx * 512 + tid) * 2; e < 4 * 128 * 128; e += G * 512 * 2) {
            const int tt_ = (e >> 7) & 127, ss_ = e & 127; const f32x2 wv = *(const f32x2*)(w_sp + e);
            *(unsigned*)(Wsb + e) = pk2(ss_ <= tt_ ? wv[0] : 0.f, ss_ + 1 <= tt_ ? wv[1] : 0.f); }
        int m = gw;
        for (; m + 3 * NGW < M; m += 4 * NGW) rms_rows4_to_bf16(x, norm1_g, XB, (size_t)m, (size_t)NGW, lane);
        for (; m < M; m += NGW) rms_rows4_to_bf16(x, norm1_g, XB, (size_t)m, 0, lane);
    }
#endif
    xcd_barrier(bar);
#ifndef SKIP_P1
    {
        pg8::Gemm g{XB, Win_t, M, NIN, DM, DM, 128}; pg8::StaticOrder S; S.init(M, NIN, G, bx, REP_P1);
        pg8::EpiIn E{Qb, Kb, Vt, Ub, Gb, q_norm_g, k_norm_g};
        pg8::gemm_phase<pg8::EpiIn, pg8::StaticOrder>(lds, g, S, E);
    }
#endif
    xcd_barrier(bar);
#ifndef SKIP_P2
    {
#ifndef SKIP_ATT
        const AttnP AP{Qb, Kb, Vt, MIX, ssqA, q_norm_g, k_norm_g};
        if (wave == 0) { unsigned long long T[18]; attn_tables(lane, T); LAS unsigned long long* D = (LAS unsigned long long*)(lds + LDS_ATAB + lane * 144);
#pragma unroll
            for (int k = 0; k < 18; ++k) D[k] = T[k]; }
        __syncthreads();
        for (int p = bx; p < 256 * REP_P2; p += G) { const int pp = p & 255, hd = pp & 7, qa = (pp >> 3) & 1, b = pp >> 4;
            attn_unit(AP, lds, b, hd, 3 - qa, wave, lane); attn_unit(AP, lds, b, hd, qa, wave, lane); }
#endif
#ifndef SKIP_GMLP
        const GmlpP GP{Ub, Gb, MIX, ln_v_g, ln_v_b, Wsb, b_sp, gmlp_out_g};
        for (int a = bx; a < 256 * REP_GM; a += G) gmlp_unit(GP, (a & 255) >> 4, a & 15, lds, wave, lane);
#endif
    }
#endif
    xcd_barrier(bar);
#ifndef SKIP_P3
    {
        pg8::Gemm g{MIX, Wout_t, M, DM, DM, DM, 128}; pg8::StaticOrder S; S.init(M, DM, G, bx, REP_P3);
        pg8::EpiOut E{x, XB, ssq, ssqA};
        pg8::gemm_phase<pg8::EpiOut, pg8::StaticOrder>(lds, g, S, E);
    }
#endif
    xcd_barrier(bar);
#ifndef SKIP_P4
#pragma unroll 1
    for (int hf = 0; hf < 2; ++hf) {
        {
            pg8::Gemm g{XB, W1_t, M / 2, FF, DM, DM, 128}; pg8::StaticOrder S; S.init(M / 2, FF, G, bx, REP_P4, 64 * hf);
            pg8::EpiUp E{Hb, ssq};
            pg8::gemm_phase<pg8::EpiUp, pg8::StaticOrder>(lds, g, S, E);
        }
        xcd_barrier(bar);
        {
            pg8::Gemm g{Hb, W2_t, M / 2, DM, FF, 64, 256 * 64 * 2}; pg8::StaticOrder S; S.init(M / 2, DM, G, bx, 1, 64 * hf);
            pg8::EpiDown E{out, XB};
            pg8::gemm_phase<pg8::EpiDown, pg8::StaticOrder>(lds, g, S, E);
        }
    }
#endif
}

extern "C" void kernel_launch(void* const* d_in, const int* in_sizes, int n_in, void* d_out, int out_size, void* d_ws, size_t ws_size, hipStream_t stream) {
    static int grid = 0;
    if (grid == 0) {
        if (n_in != 15 || in_sizes[0] != M * DM || out_size != M * DM || ws_size < WS_END) { fprintf(stderr, "kernel_launch: unexpected shapes (n_in %d, in0 %d, out %d, ws %zu)\n", n_in, n_in > 0 ? in_sizes[0] : -1, out_size, ws_size); grid = -1; return; }
        int dev = 0, cus = 0, per_cu = 0;
        if (hipGetDevice(&dev) != hipSuccess || hipDeviceGetAttribute(&cus, hipDeviceAttributeMultiprocessorCount, dev) != hipSuccess) { grid = -1; return; }
        if (hipFuncSetAttribute((const void*)mk_fwd, hipFuncAttributeMaxDynamicSharedMemorySize, LDS_BYTES) != hipSuccess) { fprintf(stderr, "kernel_launch: hipFuncSetAttribute failed\n"); grid = -1; return; }
        if (hipOccupancyMaxActiveBlocksPerMultiprocessor(&per_cu, (const void*)mk_fwd, 512, LDS_BYTES) != hipSuccess || per_cu < 1) { fprintf(stderr, "kernel_launch: occupancy query says %d blocks per CU\n", per_cu); (void)hipGetLastError(); per_cu = 1; }
        grid = cus;
    }
    if (grid < 0) return;
    Args a{};
    for (int i = 0; i < 15; ++i) a.in[i] = (const float*)d_in[i];
    a.out = (float*)d_out; a.ws = (unsigned char*)d_ws;
    if (hipMemsetAsync((char*)d_ws + WS_CTL, 0, CTL_ZERO_BYTES, stream) != hipSuccess) { fprintf(stderr, "kernel_launch: memset failed\n"); return; }
    void* kargs[] = {&a};
    const hipError_t e = hipLaunchCooperativeKernel((const void*)mk_fwd, dim3(grid), dim3(512), kargs, LDS_BYTES, stream);
    if (e != hipSuccess) fprintf(stderr, "kernel_launch: cooperative launch failed: %s (grid %d)\n", hipGetErrorString(e), grid);
}
```
